# Optimizing an MI355X kernel written in HIP

```python
import math
import jax, jax.numpy as jnp
from jax import lax
import numpy as np

D_MODEL = 2048
BATCH = 2
SEQ = 4096
DEPTH = 1

MIX_WIDTH = D_MODEL
ATTN_WIDTH = MIX_WIDTH // 2
LRU_WIDTH = MIX_WIDTH - ATTN_WIDTH
HEAD_DIM = 128
N_ATTN_HEADS = ATTN_WIDTH // HEAD_DIM
N_LRU_BLOCKS = 8
LRU_BLOCK = LRU_WIDTH // N_LRU_BLOCKS
CONV_WIDTH = 4
LRU_C = 8.0
Q_BLOCK = 128
D_FF = -(-8 * D_MODEL // (3 * 256)) * 256
IN_WIDTH = 3 * ATTN_WIDTH + 2 * LRU_WIDTH
RMS_EPS = 1e-6

kernel_name = "hymba_stickbreak_rglru_swiglu_sandwich"


def rmsnorm(x, gain):
    xf = x.astype(jnp.float32)
    var = jnp.mean(xf * xf, axis=-1, keepdims=True)
    return (xf * lax.rsqrt(var + RMS_EPS)).astype(x.dtype) * gain


def stick_breaking_attention(q, k, v):
    b, h, s, dh = q.shape
    n_blk = s // Q_BLOCK
    scale = 1.0 / math.sqrt(dh)
    qf = q.astype(jnp.float32)
    kf = k.astype(jnp.float32)
    vf = v.astype(jnp.float32)
    q_blocks = qf.reshape(b, h, n_blk, Q_BLOCK, dh).transpose(2, 0, 1, 3, 4)
    key_pos = jnp.arange(s)

    def one_block(args):
        qb, blk = args
        z = jnp.einsum('bhqd,bhkd->bhqk', qb, kf) * scale
        q_pos = blk * Q_BLOCK + jnp.arange(Q_BLOCK)
        causal = key_pos[None, :] < q_pos[:, None]
        log_beta = jax.nn.log_sigmoid(z)
        log_1m = jnp.where(causal, jax.nn.log_sigmoid(-z), 0.0)
        suffix = lax.cumsum(log_1m, axis=3, reverse=True) - log_1m
        weights = jnp.where(causal, jnp.exp(log_beta + suffix), 0.0)
        return jnp.einsum('bhqk,bhkd->bhqd', weights, vf)

    out = lax.map(one_block, (q_blocks, jnp.arange(n_blk)))
    out = out.transpose(1, 0, 3, 2, 4).reshape(b, s, h * dh)
    return out.astype(q.dtype)


def causal_depthwise_conv(x, w, bias):
    s = x.shape[1]
    xp = jnp.pad(x, ((0, 0), (CONV_WIDTH - 1, 0), (0, 0)))
    out = sum(xp[:, k:k + s, :] * w[k] for k in range(CONV_WIDTH))
    return out + bias


def block_diag_linear(x, w, bias):
    b, s, c = x.shape
    xr = x.reshape(b, s, N_LRU_BLOCKS, LRU_BLOCK)
    return jnp.einsum('bsnc,ncd->bsnd', xr, w).reshape(b, s, c) + bias


def rg_lru(x, w_rgate, b_rgate, w_igate, b_igate, lru_lambda):
    xf = x.astype(jnp.float32)
    r = jax.nn.sigmoid(block_diag_linear(x, w_rgate, b_rgate).astype(jnp.float32))
    i = jax.nn.sigmoid(block_diag_linear(x, w_igate, b_igate).astype(jnp.float32))
    log_a = LRU_C * r * jax.nn.log_sigmoid(lru_lambda.astype(jnp.float32))
    a = jnp.exp(log_a)
    mult = jnp.sqrt(-jnp.expm1(2.0 * log_a))
    bterm = mult * (i * xf)

    def combine(left, right):
        a_l, b_l = left
        a_r, b_r = right
        return a_l * a_r, a_r * b_l + b_r

    _, h = lax.associative_scan(combine, (a, bterm), axis=1)
    return h.astype(x.dtype)


def hybrid_mixer(hn, w_in, conv_w, conv_b, w_rgate, b_rgate, w_igate, b_igate, lru_lambda,
                 attn_out_norm, lru_out_norm, w_out):
    b, s, _ = hn.shape
    proj = hn @ w_in
    q, k, v, x_lru, g_lru = jnp.split(
        proj, [ATTN_WIDTH, 2 * ATTN_WIDTH, 3 * ATTN_WIDTH, 3 * ATTN_WIDTH + LRU_WIDTH], axis=-1)

    def heads(t):
        return t.reshape(b, s, N_ATTN_HEADS, HEAD_DIM).transpose(0, 2, 1, 3)

    y_attn = stick_breaking_attention(heads(q), heads(k), heads(v))

    xc = causal_depthwise_conv(x_lru, conv_w, conv_b)
    h = rg_lru(xc, w_rgate, b_rgate, w_igate, b_igate, lru_lambda)
    y_lru = h * jax.nn.gelu(g_lru)

    y = jnp.concatenate([rmsnorm(y_attn, attn_out_norm), rmsnorm(y_lru, lru_out_norm)], axis=-1)
    return y @ w_out


def swiglu_ffn(hn, w_gate, w_up, w_down):
    return (jax.nn.silu(hn @ w_gate) * (hn @ w_up)) @ w_down


def setup_inputs(seed: int = 0) -> dict:
    key = jax.random.key(seed)
    ks = jax.random.split(key, 20)
    f32 = jnp.float32

    def normal(k, shape, fan_in):
        return jax.random.normal(k, shape, f32) * (fan_in ** -0.5)

    def gain(k, shape):
        return 1.0 + 0.02 * jax.random.normal(k, shape, f32)

    def small(k, shape):
        return 0.01 * jax.random.normal(k, shape, f32)

    x = jax.random.normal(ks[0], (BATCH, SEQ, D_MODEL), f32)
    u = jax.random.uniform(ks[10], (DEPTH, LRU_WIDTH), f32, 0.9, 0.999)
    a0 = u ** (1.0 / LRU_C)
    lru_lambda = jnp.log(a0) - jnp.log1p(-a0)
    return {
        "x": x,
        "pre_mix_norm": gain(ks[1], (DEPTH, D_MODEL)),
        "post_mix_norm": gain(ks[2], (DEPTH, D_MODEL)),
        "pre_ffn_norm": gain(ks[3], (DEPTH, D_MODEL)),
        "post_ffn_norm": gain(ks[4], (DEPTH, D_MODEL)),
        "w_in": normal(ks[5], (DEPTH, D_MODEL, IN_WIDTH), D_MODEL),
        "conv_w": normal(ks[6], (DEPTH, CONV_WIDTH, LRU_WIDTH), CONV_WIDTH),
        "conv_b": small(ks[7], (DEPTH, LRU_WIDTH)),
        "w_rgate": normal(ks[8], (DEPTH, N_LRU_BLOCKS, LRU_BLOCK, LRU_BLOCK), LRU_BLOCK),
        "b_rgate": small(ks[9], (DEPTH, LRU_WIDTH)),
        "w_igate": normal(ks[11], (DEPTH, N_LRU_BLOCKS, LRU_BLOCK, LRU_BLOCK), LRU_BLOCK),
        "b_igate": small(ks[12], (DEPTH, LRU_WIDTH)),
        "lru_lambda": lru_lambda,
        "attn_out_norm": gain(ks[13], (DEPTH, ATTN_WIDTH)),
        "lru_out_norm": gain(ks[14], (DEPTH, LRU_WIDTH)),
        "w_out": normal(ks[15], (DEPTH, MIX_WIDTH, D_MODEL), MIX_WIDTH),
        "w_ffn_gate": normal(ks[16], (DEPTH, D_MODEL, D_FF), D_MODEL),
        "w_ffn_up": normal(ks[17], (DEPTH, D_MODEL, D_FF), D_MODEL),
        "w_ffn_down": normal(ks[18], (DEPTH, D_FF, D_MODEL), D_FF),
    }


def reference(x, pre_mix_norm, post_mix_norm, pre_ffn_norm, post_ffn_norm, w_in, conv_w, conv_b,
              w_rgate, b_rgate, w_igate, b_igate, lru_lambda, attn_out_norm, lru_out_norm, w_out,
              w_ffn_gate, w_ffn_up, w_ffn_down):
    for l in range(DEPTH):
        hn = rmsnorm(x, pre_mix_norm[l])
        m = hybrid_mixer(hn, w_in[l], conv_w[l], conv_b[l], w_rgate[l], b_rgate[l], w_igate[l],
                         b_igate[l], lru_lambda[l], attn_out_norm[l], lru_out_norm[l], w_out[l])
        x = x + rmsnorm(m, post_mix_norm[l])
        hn = rmsnorm(x, pre_ffn_norm[l])
        f = swiglu_ffn(hn, w_ffn_gate[l], w_ffn_up[l], w_ffn_down[l])
        x = x + rmsnorm(f, post_ffn_norm[l])
    return x
```

```cpp
#include <hip/hip_runtime.h>
#include <cstdio>
#include <cstdint>
#define MK_N_LAUNCHES 10
namespace pg8 {
#define PG8_LAS __attribute__((address_space(3)))
typedef unsigned short bf16_t;
typedef short bf16x8 __attribute__((ext_vector_type(8)));
typedef float f32x4 __attribute__((ext_vector_type(4)));
typedef unsigned u32x4 __attribute__((ext_vector_type(4)));
constexpr int BM = 256, BK = 64, HALF = 128, HTB = HALF * BK * 2  , STAGE_BYTES = 8 * HTB, NXCD = 8, WGM = 8;

__host__ __device__ __forceinline__ int lds_byte(int r, int c) { const int st = (r >> 4) * 2 + (c >> 5), rr = r & 15, cc = c & 31, ob = rr * 64 + cc * 2; return st * 1024 + (ob ^ (((ob >> 9) & 1) << 5)); }
__host__ __device__ __forceinline__ void stage_rc(int b, int& R, int& C) { const int st = b / 1024, sb = b % 1024, swz = sb ^ (((sb >> 9) & 1) << 5); R = (st >> 1) * 16 + swz / 64; C = (st & 1) * 32 + (swz % 64) / 2; }
__host__ __device__ __forceinline__ int perm32(int rho) { const int n = rho >> 4, i = rho & 15; return 8 * (i >> 2) + 4 * n + (i & 3); }

struct Unit { int pm, pn; };
struct Gemm { const bf16_t* A; const bf16_t* Bt; int M, N, K; };

struct StaticOrder {
    int nM, nN, nwg, G, c;
    __host__ __device__ void init(int M, int N, int G_, int c_) { nM = M / BM; nN = N / BM; nwg = nM * nN; G = G_; c = c_; }
    __host__ __device__ bool next(int i, Unit& u) const {
        const long L = (long)i * G + c; if (L >= nwg) return false;
        int wgid = (int)L; { const int q = nwg / NXCD, r = nwg % NXCD, xcd = wgid % NXCD, off = wgid / NXCD; wgid = (xcd < r ? xcd * (q + 1) : r * (q + 1) + (xcd - r) * q) + off; }
        const int nig = WGM * nN, gid = wgid / nig, fm = gid * WGM, gsz = (nM - fm) < WGM ? (nM - fm) : WGM;
        u.pm = fm + ((wgid % nig) % gsz); u.pn = (wgid % nig) / gsz; return true;
    }
    __device__ __forceinline__ void a_ready(const Unit&) const {}
    __device__ __forceinline__ void done(const Unit&) const {}
};

__device__ __forceinline__ unsigned cvt_pk_bf16(float lo, float hi) { unsigned r; asm volatile("v_cvt_pk_bf16_f32 %0, %1, %2" : "=v"(r) : "v"(lo), "v"(hi)); return r; }
typedef float f32x2 __attribute__((ext_vector_type(2)));
__device__ __forceinline__ f32x2 gelu_pk(f32x2 v) {
    const f32x2 av = __builtin_elementwise_abs(v), d = av * 0.2316418882f + 1.0f;
    f32x2 t; t.x = __builtin_amdgcn_rcpf(d.x); t.y = __builtin_amdgcn_rcpf(d.y);
    f32x2 q = t * 0.5307027145f + (-0.7265760135f); q = q * t + 0.7107068705f; q = q * t + (-0.142248368f); q = q * t + 0.127414796f; q = q * t;
    const f32x2 s = (v * v) * (-0.72134752044f);
    f32x2 e; e.x = __builtin_amdgcn_exp2f(s.x); e.y = __builtin_amdgcn_exp2f(s.y);
    const f32x2 m = v * (q * e), r = v - m;
    f32x2 o; o.x = v.x < 0.f ? m.x : r.x; o.y = v.y < 0.f ? m.y : r.y; return o;
}

template <int ACT  > struct EpiBf16 {
    static constexpr bool PERM = true, AFTER_DRAIN = false; static_assert(ACT == 0 || ACT == 1, "EpiBf16: ACT is 0 (none) or 1 (gelu_pk)");
    bf16_t* O; int ldc; const float* bias; int split_cols; size_t split_stride; float scale0;
    __device__ __forceinline__ void operator()(const f32x4 (&acc)[2][2][4][2], const Unit& u, int wr, int wc, int fr, int fq) const {
        const int row0 = u.pm * BM + wr * 64 + fr; int colt = u.pn * BM; bf16_t* base = O;
        float sc = 1.f; if (split_cols) { const int t = colt / split_cols; base += (size_t)t * split_stride; colt -= t * split_cols; if (t == 0) sc = scale0; }
        const int col0 = colt + wc * 32 + 8 * fq, bcol0 = u.pn * BM + wc * 32 + 8 * fq;
        f32x4 bv[2][2];
#pragma unroll
        for (int bj = 0; bj < 2; ++bj)
#pragma unroll
            for (int n = 0; n < 2; ++n) bv[bj][n] = bias ? *(const f32x4*)(bias + bcol0 + bj * HALF + 4 * n) : (f32x4){0.f, 0.f, 0.f, 0.f};
#pragma unroll
        for (int ai = 0; ai < 2; ++ai)
#pragma unroll
            for (int m = 0; m < 4; ++m) { bf16_t* rowp = base + (size_t)(row0 + ai * HALF + m * 16) * ldc + col0;
#pragma unroll
                for (int bj = 0; bj < 2; ++bj) { f32x4 v0 = acc[ai][bj][m][0] + bv[bj][0], v1 = acc[ai][bj][m][1] + bv[bj][1];
                    if (ACT == 1) { f32x2 a = gelu_pk((f32x2){v0[0], v0[1]}), b = gelu_pk((f32x2){v0[2], v0[3]}), c = gelu_pk((f32x2){v1[0], v1[1]}), d = gelu_pk((f32x2){v1[2], v1[3]});
                        v0 = (f32x4){a.x, a.y, b.x, b.y}; v1 = (f32x4){c.x, c.y, d.x, d.y}; }
                    v0 = v0 * sc; v1 = v1 * sc; u32x4 w; w.x = cvt_pk_bf16(v0[0], v0[1]); w.y = cvt_pk_bf16(v0[2], v0[3]); w.z = cvt_pk_bf16(v1[0], v1[1]); w.w = cvt_pk_bf16(v1[2], v1[3]);
                    *(u32x4*)(rowp + bj * HALF) = w; } }
    }
};

struct PanelStats {
    unsigned* xbuf;
    unsigned* cnt;
    unsigned* tmo;
    int ntn; float eps;
    unsigned code;
    __device__ __forceinline__ bool run(const f32x4 (&v)[2][2][4][2], const Unit& u, int wr, int wc, int fr, int fq, PG8_LAS unsigned char* lds, int wid, int lane) const {
        typedef float f32x2v __attribute__((ext_vector_type(2)));
        PG8_LAS f32x2v* P = (PG8_LAS f32x2v*)lds;
        PG8_LAS f32x2v* S = (PG8_LAS f32x2v*)(lds + 8192);
        PG8_LAS unsigned* flag = (PG8_LAS unsigned*)(lds + 8192 + 2048);
#pragma unroll
        for (int ai = 0; ai < 2; ++ai)
#pragma unroll
            for (int m = 0; m < 4; ++m) {
                float s = 0.f;
#pragma unroll
                for (int bj = 0; bj < 2; ++bj)
#pragma unroll
                    for (int n = 0; n < 2; ++n) { const f32x4 x = v[ai][bj][m][n]; s += (x[0] + x[1]) + (x[2] + x[3]); }
                s += __shfl_xor(s, 16); s += __shfl_xor(s, 32);
                const float mw = s * (1.0f / 64.0f); float q = 0.f;
#pragma unroll
                for (int bj = 0; bj < 2; ++bj)
#pragma unroll
                    for (int n = 0; n < 2; ++n) { const f32x4 d = v[ai][bj][m][n] - mw; q += (d[0] * d[0] + d[1] * d[1]) + (d[2] * d[2] + d[3] * d[3]); }
                q += __shfl_xor(q, 16); q += __shfl_xor(q, 32);
                if (fq == 0) P[(ai * HALF + wr * 64 + m * 16 + fr) * 4 + wc] = (f32x2v){mw, q};
            }
        asm volatile("s_waitcnt lgkmcnt(0)" ::: "memory"); __builtin_amdgcn_s_barrier(); asm volatile("" ::: "memory");
#if defined(BROKEN_EXCHANGE_NO_WAIT)
#warning BROKEN CONTROL BUILD: the row-statistics exchange does not wait; results are wrong by design
        if (blockIdx.x >= 64) { const long long t0_ = clock64(); while (clock64() - t0_ < 60000) __builtin_amdgcn_s_sleep(8); }
#endif
        const int row = wid * 32 + (lane & 31);
        if (lane < 32) {
            const f32x2v a = P[row * 4 + 0], b = P[row * 4 + 1], c = P[row * 4 + 2], d = P[row * 4 + 3];
            const float mt = (a.x + b.x + c.x + d.x) * 0.25f;
            const float da = a.x - mt, db = b.x - mt, dc = c.x - mt, dd = d.x - mt;
            const float m2 = (a.y + b.y) + (c.y + d.y) + 64.0f * ((da * da + db * db) + (dc * dc + dd * dd));
            unsigned long long* slot = (unsigned long long*)xbuf + ((size_t)(u.pm * BM + row) * 4 + u.pn);
            __hip_atomic_store(slot, ((unsigned long long)__float_as_uint(m2) << 32) | __float_as_uint(mt), __ATOMIC_RELAXED, __HIP_MEMORY_SCOPE_AGENT);
        }
        asm volatile("s_waitcnt vmcnt(0)" ::: "memory");
        if (lane == 0) __hip_atomic_fetch_add(cnt + 64 * u.pm, 1u, __ATOMIC_RELAXED, __HIP_MEMORY_SCOPE_AGENT);
        if (wid == 0) {
            bool dead = false; const unsigned long long t0 = __builtin_amdgcn_s_memrealtime(); const unsigned want = 8u * (unsigned)ntn;
            for (;;) {
#if defined(BROKEN_EXCHANGE_NO_WAIT)
                break;
#endif
                if ((unsigned)__builtin_amdgcn_readfirstlane(__hip_atomic_load(cnt + 64 * u.pm, __ATOMIC_RELAXED, __HIP_MEMORY_SCOPE_AGENT)) >= want) break;
                if (__builtin_amdgcn_s_memrealtime() - t0 > 2000000ull) {
                    if (lane == 0) { unsigned expect = 0u; __hip_atomic_compare_exchange_strong(tmo + 1, &expect, code | (unsigned)(u.pm & 0xff), __ATOMIC_RELAXED, __ATOMIC_RELAXED, __HIP_MEMORY_SCOPE_AGENT);
                                     __hip_atomic_store(tmo, 1u, __ATOMIC_RELAXED, __HIP_MEMORY_SCOPE_AGENT); }
                    dead = true; break; }
                __builtin_amdgcn_s_sleep(2);
            }
            __builtin_amdgcn_fence(__ATOMIC_ACQUIRE, "agent");
            if (lane == 0) flag[0] = dead ? 1u : 0u;
        }
        asm volatile("s_waitcnt vmcnt(0) lgkmcnt(0)" ::: "memory"); __builtin_amdgcn_s_barrier(); asm volatile("" ::: "memory");
        const bool bad = flag[0] != 0u;
        if (lane < 32) {
            const unsigned long long* slot = (const unsigned long long*)xbuf + (size_t)(u.pm * BM + row) * 4; float mt[4], m2[4]; float ms = 0.f;
#pragma unroll
            for (int t = 0; t < 4; ++t) { if (t < ntn) { const unsigned long long w = __hip_atomic_load(slot + t, __ATOMIC_RELAXED, __HIP_MEMORY_SCOPE_AGENT); mt[t] = __uint_as_float((unsigned)w); m2[t] = __uint_as_float((unsigned)(w >> 32)); } else { mt[t] = 0.f; m2[t] = 0.f; } ms += mt[t]; }
            const float mean = ms / (float)ntn; float q = 0.f;
#pragma unroll
            for (int t = 0; t < 4; ++t) if (t < ntn) { const float dm = mt[t] - mean; q += m2[t] + 256.0f * dm * dm; }
            S[row] = (f32x2v){mean, 1.0f / sqrtf(q / (256.0f * (float)ntn) + eps)};
        }
        asm volatile("s_waitcnt lgkmcnt(0)" ::: "memory"); __builtin_amdgcn_s_barrier(); asm volatile("" ::: "memory");
        return bad;
    }
};
struct EpiLnRes {
    static constexpr bool PERM = false, AFTER_DRAIN = true;
    const float* base; float* out; int ldc; const float* bias; PanelStats st; unsigned poison;
    __device__ __forceinline__ void fused(f32x4 (&acc)[2][2][4][2], const Unit& u, int wr, int wc, int fr, int fq, PG8_LAS unsigned char* lds, int wid, int lane) const {
        typedef float f32x2v __attribute__((ext_vector_type(2)));
        const PG8_LAS f32x2v* S = (const PG8_LAS f32x2v*)(lds + 8192);
        const int col0 = u.pn * BM + wc * 32 + 4 * fq;
#pragma unroll
        for (int bj = 0; bj < 2; ++bj)
#pragma unroll
            for (int n = 0; n < 2; ++n) { const f32x4 bv = bias ? *(const f32x4*)(bias + col0 + bj * HALF + n * 16) : (f32x4){0.f, 0.f, 0.f, 0.f};
#pragma unroll
                for (int ai = 0; ai < 2; ++ai)
#pragma unroll
                    for (int m = 0; m < 4; ++m) acc[ai][bj][m][n] += bv; }
        f32x4 pre[4][2][2];
#pragma unroll
        for (int m = 0; m < 4; ++m) { const size_t off = (size_t)(u.pm * BM + wr * 64 + m * 16 + fr) * ldc + col0;
#pragma unroll
            for (int bj = 0; bj < 2; ++bj)
#pragma unroll
                for (int n = 0; n < 2; ++n) pre[m][bj][n] = *(const f32x4*)(base + off + bj * HALF + n * 16); }
        const bool bad = st.run(acc, u, wr, wc, fr, fq, lds, wid, lane) || poison != 0u;
        const float qnan = __builtin_nanf("");
#pragma unroll
        for (int ai = 0; ai < 2; ++ai)
#pragma unroll
            for (int m = 0; m < 4; ++m) { const int r = ai * HALF + wr * 64 + m * 16 + fr; const f32x2v sr = S[r]; const size_t off = (size_t)(u.pm * BM + r) * ldc + col0;
#pragma unroll
                for (int bj = 0; bj < 2; ++bj)
#pragma unroll
                    for (int n = 0; n < 2; ++n) { const f32x4 bs = ai == 0 ? pre[m][bj][n] : *(const f32x4*)(base + off + bj * HALF + n * 16); f32x4 o = bs + (acc[ai][bj][m][n] - sr.x) * sr.y;
                        if (bad) o = (f32x4){qnan, qnan, qnan, qnan}; *(f32x4*)(out + off + bj * HALF + n * 16) = o; }
                if (m & 1) asm volatile("" ::: "memory"); }
    }
};
struct EpiLnResLn {
    static constexpr bool PERM = false, AFTER_DRAIN = true;
    const float* base; float* out; bf16_t* xn; int ldc; const float* bias; PanelStats st1, st2; unsigned poison;
    __device__ __forceinline__ void fused(f32x4 (&acc)[2][2][4][2], const Unit& u, int wr, int wc, int fr, int fq, PG8_LAS unsigned char* lds, int wid, int lane) const {
        typedef float f32x2v __attribute__((ext_vector_type(2))); typedef unsigned u32x2v __attribute__((ext_vector_type(2)));
        const PG8_LAS f32x2v* S = (const PG8_LAS f32x2v*)(lds + 8192);
        const int col0 = u.pn * BM + wc * 32 + 4 * fq;
#pragma unroll
        for (int bj = 0; bj < 2; ++bj)
#pragma unroll
            for (int n = 0; n < 2; ++n) { const f32x4 bv = bias ? *(const f32x4*)(bias + col0 + bj * HALF + n * 16) : (f32x4){0.f, 0.f, 0.f, 0.f};
#pragma unroll
                for (int ai = 0; ai < 2; ++ai)
#pragma unroll
                    for (int m = 0; m < 4; ++m) acc[ai][bj][m][n] += bv; }
        bool bad = st1.run(acc, u, wr, wc, fr, fq, lds, wid, lane) || poison != 0u;
        const float qnan = __builtin_nanf("");
#pragma unroll
        for (int ai = 0; ai < 2; ++ai)
#pragma unroll
            for (int m = 0; m < 4; ++m) { const int r = ai * HALF + wr * 64 + m * 16 + fr; const f32x2v sr = S[r]; const size_t off = (size_t)(u.pm * BM + r) * ldc + col0;
#pragma unroll
                for (int bj = 0; bj < 2; ++bj)
#pragma unroll
                    for (int n = 0; n < 2; ++n) { const f32x4 bs = *(const f32x4*)(base + off + bj * HALF + n * 16); acc[ai][bj][m][n] = bs + (acc[ai][bj][m][n] - sr.x) * sr.y; }
                asm volatile("" : "+v"(acc[ai][0][m][0]), "+v"(acc[ai][0][m][1]), "+v"(acc[ai][1][m][0]), "+v"(acc[ai][1][m][1]));
                if (m & 1) asm volatile("" ::: "memory"); }
        const bool bad1 = bad;
        bad = st2.run(acc, u, wr, wc, fr, fq, lds, wid, lane) || bad;
#pragma unroll
        for (int ai = 0; ai < 2; ++ai)
#pragma unroll
            for (int m = 0; m < 4; ++m) { const int r = ai * HALF + wr * 64 + m * 16 + fr; const f32x2v sr = S[r]; const size_t off = (size_t)(u.pm * BM + r) * ldc + col0;
#pragma unroll
                for (int bj = 0; bj < 2; ++bj)
#pragma unroll
                    for (int n = 0; n < 2; ++n) { const f32x4 x1 = acc[ai][bj][m][n]; *(f32x4*)(out + off + bj * HALF + n * 16) = bad1 ? (f32x4){qnan, qnan, qnan, qnan} : x1;
                        const f32x4 o = (x1 - sr.x) * sr.y; u32x2v w; w.x = cvt_pk_bf16(o[0], o[1]); w.y = cvt_pk_bf16(o[2], o[3]);
                        if (bad) { w.x = 0x7fc07fc0u; w.y = 0x7fc07fc0u; } *(u32x2v*)(xn + off + bj * HALF + n * 16) = w; }
                asm volatile("" ::: "memory"); }
    }
};

template <class Epi, class Sched, bool ALIGN_EPI = false, bool SP2 = false>
__device__ __forceinline__ void gemm_phase(PG8_LAS unsigned char* lds, const Gemm g, const Sched& S, const Epi& E) {
    const int tid = threadIdx.x, wid = __builtin_amdgcn_readfirstlane(tid >> 6), lane = tid & 63, wr = wid >> 2, wc = wid & 3, fr = lane & 15, fq = lane >> 4;
    const int K = g.K, nt = K / BK;
    unsigned voffA[2], voffB[2];
#pragma unroll
    for (int i = 0; i < 2; ++i) { int R, C; stage_rc(tid * 16 + i * 8192, R, C); const int Rb = Epi::PERM ? ((R & ~31) + perm32(R & 31)) : R;
        voffA[i] = (unsigned)(R * K + C) * 2u; voffB[i] = (unsigned)(Rb * K + C) * 2u; }
    const size_t kstep = (size_t)(BK * 2);
    const size_t hstep = (size_t)HALF * K * 2;
    const size_t tstep = 2 * hstep;
    const unsigned ldsw = (unsigned)wid * 1024u;
    const int aoff = lds_byte(wr * 64 + fr, fq * 8), boff = lds_byte(wc * 32 + fr, fq * 8);
#define PG8_SA(b, h) (((b) * 2 + (h)) * HTB)
#define PG8_SB(b, h) ((4 + (b) * 2 + (h)) * HTB)
#define PG8_STAGE(bufoff, gbase, voff) do { _Pragma("unroll") for (int _i = 0; _i < 2; ++_i) \
        __builtin_amdgcn_global_load_lds((const unsigned*)((const char*)(gbase) + (voff)[_i]), (PG8_LAS unsigned*)(lds + (bufoff) + ldsw + _i * 8192), 16, 0, 0); } while (0)
#define PG8_LDA(dst, b, h) do { _Pragma("unroll") for (int m = 0; m < 4; ++m) _Pragma("unroll") for (int k = 0; k < 2; ++k) dst[m][k] = *(const PG8_LAS bf16x8*)(lds + PG8_SA(b, h) + aoff + m * 2048 + k * 1024); } while (0)
#define PG8_LDB(dst, b, h) do { _Pragma("unroll") for (int n = 0; n < 2; ++n) _Pragma("unroll") for (int k = 0; k < 2; ++k) dst[n][k] = *(const PG8_LAS bf16x8*)(lds + PG8_SB(b, h) + boff + n * 2048 + k * 1024); } while (0)
#define PG8_MMA(ai, bj, At, Bt) do { __builtin_amdgcn_s_setprio(1); _Pragma("unroll") for (int m = 0; m < 4; ++m) _Pragma("unroll") for (int n = 0; n < 2; ++n) _Pragma("unroll") for (int k = 0; k < 2; ++k) \
        acc[ai][bj][m][n] = __builtin_amdgcn_mfma_f32_16x16x32_bf16(Bt[n][k], At[m][k], acc[ai][bj][m][n], 0, 0, 0); __builtin_amdgcn_s_setprio(0); } while (0)
#define PG8_WAIT_V(n) asm volatile("s_waitcnt vmcnt(" #n ")" ::: "memory")
#define PG8_WAIT_L(n) asm volatile("s_waitcnt lgkmcnt(" #n ")" ::: "memory")
#define PG8_BAR __builtin_amdgcn_s_barrier()
#define PG8_SCHED __builtin_amdgcn_sched_barrier(0)
    Unit cur, nxt; int ui = 0;
    if (!S.next(0, cur)) return;
    f32x4 acc[2][2][4][2];
#pragma unroll
    for (int a = 0; a < 2; ++a)
#pragma unroll
        for (int b = 0; b < 2; ++b)
#pragma unroll
            for (int m = 0; m < 4; ++m)
#pragma unroll
                for (int n = 0; n < 2; ++n) acc[a][b][m][n] = (f32x4){0.f, 0.f, 0.f, 0.f};
    bf16x8 At[4][2], B0[2][2], B1[2][2];
    const char* cA = (const char*)g.A + (size_t)cur.pm * tstep; const char* cB = (const char*)g.Bt + (size_t)cur.pn * tstep;
    S.a_ready(cur);
    if constexpr (SP2) {
        PG8_STAGE(PG8_SB(0, 0), cB, voffB); PG8_STAGE(PG8_SB(0, 1), cB + hstep, voffB); PG8_STAGE(PG8_SA(0, 0), cA, voffA); PG8_STAGE(PG8_SA(0, 1), cA + hstep, voffA);
        if (wr == 1) PG8_BAR;
        PG8_WAIT_V(2); PG8_BAR;
        PG8_STAGE(PG8_SB(1, 0), cB + kstep, voffB); PG8_STAGE(PG8_SA(1, 0), cA + kstep, voffA); PG8_STAGE(PG8_SB(1, 1), cB + hstep + kstep, voffB);
        PG8_WAIT_V(6); PG8_BAR;
    } else {
        PG8_STAGE(PG8_SB(0, 0), cB, voffB); PG8_STAGE(PG8_SA(0, 0), cA, voffA); PG8_STAGE(PG8_SB(0, 1), cB + hstep, voffB); PG8_STAGE(PG8_SA(0, 1), cA + hstep, voffA);
        if (wr == 1) PG8_BAR;
        PG8_WAIT_V(4); PG8_BAR;
        PG8_STAGE(PG8_SB(1, 0), cB + kstep, voffB); PG8_STAGE(PG8_SA(1, 0), cA + kstep, voffA); PG8_STAGE(PG8_SB(1, 1), cB + hstep + kstep, voffB);
        PG8_WAIT_V(6); PG8_BAR;
    }
    for (;;) {
        const bool has_next = S.next(ui + 1, nxt);
        const char* nA = has_next ? (const char*)g.A + (size_t)nxt.pm * tstep : cA; const char* nB = has_next ? (const char*)g.Bt + (size_t)nxt.pn * tstep : cB;
        for (int t = 0; t < nt; t += 2) {
            if constexpr (Epi::MIDK) { if (t == (nt >> 1)) E.midk(acc, cur, wr, wc, fr, fq, lds); }
            const bool last = (t == nt - 2);
            const char* a1 = cA + (size_t)(t + 1) * kstep;
            const char* a2 = last ? nA : cA + (size_t)(t + 2) * kstep; const char* b2 = last ? nB : cB + (size_t)(t + 2) * kstep;
            const char* a3 = a2 + kstep; const char* b3 = b2 + kstep;
            if (last && has_next) S.a_ready(nxt);
            if constexpr (SP2) {
            PG8_LDB(B0, 0, 0); PG8_LDB(B1, 0, 1); PG8_SCHED; PG8_LDA(At, 0, 0); PG8_STAGE(PG8_SA(1, 1), a1 + hstep, voffA);
            PG8_WAIT_V(8); PG8_WAIT_L(0); PG8_BAR; PG8_MMA(0, 0, At, B0); PG8_MMA(0, 1, At, B1); PG8_BAR; PG8_SCHED;
            PG8_LDA(At, 0, 1); PG8_STAGE(PG8_SB(0, 0), b2, voffB); PG8_STAGE(PG8_SB(0, 1), b2 + hstep, voffB); PG8_STAGE(PG8_SA(0, 0), a2, voffA);
            PG8_WAIT_V(8); PG8_WAIT_L(0); PG8_BAR; PG8_MMA(1, 0, At, B0); PG8_MMA(1, 1, At, B1); PG8_BAR; PG8_SCHED;
            PG8_LDB(B0, 1, 0); PG8_LDB(B1, 1, 1); PG8_SCHED; PG8_LDA(At, 1, 0); PG8_STAGE(PG8_SA(0, 1), a2 + hstep, voffA);
            PG8_WAIT_V(8); PG8_WAIT_L(0); PG8_BAR; PG8_MMA(0, 0, At, B0); PG8_MMA(0, 1, At, B1); PG8_BAR; PG8_SCHED;
            PG8_LDA(At, 1, 1); PG8_STAGE(PG8_SB(1, 0), b3, voffB); PG8_STAGE(PG8_SB(1, 1), b3 + hstep, voffB); PG8_STAGE(PG8_SA(1, 0), a3, voffA);
            PG8_WAIT_V(8); PG8_WAIT_L(0); PG8_BAR; PG8_MMA(1, 0, At, B0); PG8_MMA(1, 1, At, B1); PG8_BAR; PG8_SCHED;
            } else {
            PG8_LDB(B0, 0, 0); PG8_SCHED; PG8_LDA(At, 0, 0); PG8_STAGE(PG8_SA(1, 1), a1 + hstep, voffA);
            PG8_WAIT_L(8); PG8_BAR; PG8_WAIT_L(0); PG8_MMA(0, 0, At, B0); PG8_BAR; PG8_SCHED;
            PG8_LDB(B1, 0, 1); PG8_STAGE(PG8_SB(0, 0), b2, voffB);
            PG8_BAR; PG8_WAIT_L(0); PG8_MMA(0, 1, At, B1); PG8_BAR;
            PG8_LDA(At, 0, 1); PG8_STAGE(PG8_SA(0, 0), a2, voffA);
            PG8_BAR; PG8_WAIT_L(0); PG8_MMA(1, 0, At, B0); PG8_BAR; PG8_SCHED;
            PG8_STAGE(PG8_SB(0, 1), b2 + hstep, voffB);
            PG8_WAIT_V(6); PG8_BAR; PG8_MMA(1, 1, At, B1); PG8_BAR;
            PG8_LDB(B0, 1, 0); PG8_SCHED; PG8_LDA(At, 1, 0); PG8_STAGE(PG8_SA(0, 1), a2 + hstep, voffA);
            PG8_WAIT_L(8); PG8_BAR; PG8_WAIT_L(0); PG8_MMA(0, 0, At, B0); PG8_BAR; PG8_SCHED;
            PG8_LDB(B1, 1, 1); PG8_STAGE(PG8_SB(1, 0), b3, voffB);
            PG8_BAR; PG8_WAIT_L(0); PG8_MMA(0, 1, At, B1); PG8_BAR;
            PG8_LDA(At, 1, 1); PG8_STAGE(PG8_SA(1, 0), a3, voffA);
            PG8_BAR; PG8_WAIT_L(0); PG8_MMA(1, 0, At, B0); PG8_BAR; PG8_SCHED;
            PG8_STAGE(PG8_SB(1, 1), b3 + hstep, voffB);
            PG8_WAIT_V(6); PG8_BAR; PG8_MMA(1, 1, At, B1); PG8_BAR;
            }
        }
        if constexpr (ALIGN_EPI) { if (wr == 0) PG8_BAR; }
        if constexpr (!Epi::AFTER_DRAIN) { E(acc, cur, wr, wc, fr, fq); S.done(cur); }
        if (!has_next) break;
#pragma unroll
        for (int a = 0; a < 2; ++a)
#pragma unroll
            for (int b = 0; b < 2; ++b)
#pragma unroll
                for (int m = 0; m < 4; ++m)
#pragma unroll
                    for (int n = 0; n < 2; ++n) acc[a][b][m][n] = (f32x4){0.f, 0.f, 0.f, 0.f};
        cur = nxt; cA = nA; cB = nB; ++ui;
        if constexpr (ALIGN_EPI) { if (wr == 1) PG8_BAR; }
    }
    PG8_WAIT_V(0);
    if constexpr (!ALIGN_EPI) { if (wr == 0) PG8_BAR; }
    PG8_BAR;
    if constexpr (Epi::AFTER_DRAIN) { E.fused(acc, cur, wr, wc, fr, fq, lds, wid, lane); S.done(cur); }
#undef PG8_SA
#undef PG8_SB
#undef PG8_STAGE
#undef PG8_LDA
#undef PG8_LDB
#undef PG8_MMA
#undef PG8_WAIT_V
#undef PG8_WAIT_L
#undef PG8_BAR
#undef PG8_SCHED
}
}

constexpr int NWAVES = 8;
constexpr int BATCH = 2, SEQ = 4096, D = 2048, M = BATCH * SEQ;
constexpr int AW = 1024, LW = 1024, HD = 128, NH = 8, NLB = 8, LBS = 128, FF = 5632, INW = 5120, GUW = 2 * FF;
constexpr float RMS_EPS = 1e-6f;
constexpr float C2 = 1.4426950408889634f * 0.08838834764831845f;

#ifndef MK_N_LAUNCHES
#define MK_N_LAUNCHES 1
#endif

constexpr size_t MiB = 1u << 20;
constexpr size_t WS_CTL = 0, CTL_ZERO_BYTES = 1 * MiB;
constexpr size_t WS_WIN = 2 * MiB;
constexpr size_t WS_WOUT = 22 * MiB;
constexpr size_t WS_WGU = 30 * MiB;
constexpr size_t WS_WDN = 74 * MiB;
constexpr size_t WS_WRG = 96 * MiB;
constexpr size_t WS_WIG = WS_WRG + 256 * 1024;
constexpr size_t WS_SSQA = 97 * MiB;
constexpr size_t WS_SSQL = WS_SSQA + 256 * 1024;
constexpr size_t WS_XCH = 98 * MiB;
constexpr size_t WS_XN = 100 * MiB;
constexpr size_t WS_Q = 132 * MiB, WS_K = 148 * MiB, WS_VT = 164 * MiB, WS_XL = 180 * MiB, WS_GL = 196 * MiB;
constexpr size_t WS_Y = 212 * MiB;
constexpr size_t WS_H = 132 * MiB;
constexpr size_t WS_MBUF = 132 * MiB;
constexpr size_t WS_FBUF = 2 * MiB;
constexpr size_t WS_ATMP = WS_XN;
constexpr size_t WS_END = 256 * MiB;
constexpr size_t WS_LAGG = 244 * MiB;

constexpr int CW_TMO = 0, CW_CODE = 1, CW_BAR = 4096;

constexpr int RING_OFF = 0, RING_BYTES = 131072;
constexpr int LDSCTL_OFF = RING_BYTES, MISC_OFF = LDSCTL_OFF + 320;
constexpr int RS_OFF = RING_BYTES + 1024;
constexpr int LDS_BYTES = 147456;

#define GAS __attribute__((address_space(1)))
#define LAS __attribute__((address_space(3)))
typedef unsigned short bf16;
typedef unsigned v4u __attribute__((ext_vector_type(4)));
typedef unsigned v2u __attribute__((ext_vector_type(2)));
typedef float f32x4 __attribute__((ext_vector_type(4)));
typedef float f32x2 __attribute__((ext_vector_type(2)));
typedef GAS unsigned gu32;
typedef GAS unsigned long long gu64;
#define RLX_AGENT __ATOMIC_RELAXED, __HIP_MEMORY_SCOPE_AGENT
#define LDS_WAIT() asm volatile("s_waitcnt lgkmcnt(0)" ::: "memory")
#define VM_WAIT() asm volatile("s_waitcnt vmcnt(0)" ::: "memory")
__device__ __forceinline__ unsigned f2bf(float f) { unsigned u = __builtin_bit_cast(unsigned, f); return (u + 0x7fffu + ((u >> 16) & 1u)) >> 16; }
__device__ __forceinline__ unsigned pk2(float lo, float hi) { return f2bf(lo) | (f2bf(hi) << 16); }
__device__ __forceinline__ float bf2f(unsigned h) { return __builtin_bit_cast(float, h << 16); }
__device__ __forceinline__ float bflo(unsigned w) { return __builtin_bit_cast(float, w << 16); }
__device__ __forceinline__ float bfhi(unsigned w) { return __builtin_bit_cast(float, w & 0xffff0000u); }

#define XB_TMO      128
#define XB_XCNT(j)  (256  + 64 * (j))
#define XB_XSUB(j)  (1280 + 64 * (j))
#define XB_XGEN(j)  (2304 + 64 * (j))
#define XB_TOP      3328
#define XB_TOPGEN   3392
#define XCD_BAR_WORDS 3456
#define XB_SPIN_CAP (1u << 18)
__device__ __forceinline__ unsigned xb_ld(unsigned* p)              { return __hip_atomic_load(p, __ATOMIC_RELAXED, __HIP_MEMORY_SCOPE_AGENT); }
__device__ __forceinline__ unsigned xb_add(unsigned* p, unsigned v) { return __hip_atomic_fetch_add(p, v, __ATOMIC_RELAXED, __HIP_MEMORY_SCOPE_AGENT); }
__device__ __forceinline__ unsigned xb_xcc_id() { return (unsigned)__builtin_amdgcn_s_getreg((3 << 11) | 20) & 0xFu; }
#define XB_SPIN(cond, bar) do { unsigned _sp = 0; while (cond) { __builtin_amdgcn_s_sleep(1); \
    if ((++_sp & 255u) == 0u) { if (xb_ld(&(bar)[XB_TMO])) break; if (_sp > XB_SPIN_CAP) { atomicAdd(&(bar)[XB_TMO], 1u); break; } } } } while (0)
struct XcdBarrier { unsigned* bar; unsigned x; volatile LAS unsigned* st; };
__device__ __forceinline__ XcdBarrier xcd_barrier_post(unsigned* bar, volatile LAS unsigned* st) {
    XcdBarrier b; b.bar = bar; b.x = xb_xcc_id(); b.st = st;
    if (threadIdx.x == 0) (void)xb_add(&bar[XB_XCNT(b.x)], 1u);
    return b;
}
__device__ __forceinline__ void xcd_barrier_complete(unsigned* bar, unsigned x, unsigned& nloc, unsigned& nx) {
    const unsigned G = gridDim.x * gridDim.y * gridDim.z;
    unsigned sum, cnt, mine, sp = 0u;
    for (;;) {
        sum = 0u; cnt = 0u; mine = 0u;
#pragma unroll
        for (unsigned j = 0; j < 16; ++j) { const unsigned c = xb_ld(&bar[XB_XCNT(j)]); sum += c; cnt += (c > 0u) ? 1u : 0u; mine = (j == x) ? c : mine; }
        if (sum == G) break;
        __builtin_amdgcn_s_sleep(1);
        if ((++sp & 255u) == 0u) { if (xb_ld(&bar[XB_TMO])) break; if (sp > XB_SPIN_CAP) { atomicAdd(&bar[XB_TMO], 1u); break; } }
    }
    nloc = mine > 0u ? mine : 1u; nx = cnt > 0u ? cnt : 1u;
}
__device__ __forceinline__ void xcd_barrier(const XcdBarrier& b) {
    asm volatile("s_waitcnt vmcnt(0)" ::: "memory");
    __syncthreads();
    if (threadIdx.x == 0) {
        unsigned* bar = b.bar;
        __builtin_amdgcn_s_waitcnt(0);
        unsigned nloc = b.st[0], nx = b.st[1];
        if (nloc == 0u) { xcd_barrier_complete(bar, b.x, nloc, nx); b.st[0] = nloc; b.st[1] = nx; }
        const unsigned old = xb_add(&bar[XB_XSUB(b.x)], 1u);
        const unsigned gen = old / nloc;
        if (old + 1u == (gen + 1u) * nloc) {
            __builtin_amdgcn_fence(__ATOMIC_RELEASE, "agent");
            asm volatile("s_waitcnt vmcnt(0)" ::: "memory");
            const unsigned og = xb_add(&bar[XB_TOP], 1u);
            const unsigned tg = og / nx;
            if (og + 1u == (tg + 1u) * nx) xb_add(&bar[XB_TOPGEN], 1u);
            else XB_SPIN(xb_ld(&bar[XB_TOPGEN]) == tg, bar);
            __builtin_amdgcn_fence(__ATOMIC_ACQUIRE, "agent");
            xb_add(&bar[XB_XGEN(b.x)], 1u);
            asm volatile("s_waitcnt vmcnt(0)" ::: "memory");
        } else {
            XB_SPIN(xb_ld(&bar[XB_XGEN(b.x)]) == gen, bar);
            __builtin_amdgcn_fence(__ATOMIC_ACQUIRE, "agent");
            asm volatile("s_waitcnt vmcnt(0)" ::: "memory");
        }
    }
    __syncthreads();
}

namespace pg8 {
struct EpiInProj {
    static constexpr bool PERM = true, AFTER_DRAIN = false, MIDK = false;
    bf16_t *Q, *K, *VT, *XL, *GL;
    __device__ __forceinline__ void operator()(const f32x4 (&acc)[2][2][4][2], const Unit& u, int wr, int wc, int fr, int fq) const {
        const int t = u.pn >> 2, colt = (u.pn & 3) * BM;
        const int row0 = u.pm * BM + wr * 64 + fr;
        if (t != 2) {
            bf16_t* base = (t == 0) ? Q : (t == 1) ? K : (t == 3) ? XL : GL;
            const float sc = (t == 0) ? C2 : 1.f;
            const int col0 = colt + wc * 32 + 8 * fq;
#pragma unroll
            for (int ai = 0; ai < 2; ++ai)
#pragma unroll
                for (int m = 0; m < 4; ++m) { bf16_t* rowp = base + (size_t)(row0 + ai * HALF + m * 16) * 1024 + col0;
#pragma unroll
                    for (int bj = 0; bj < 2; ++bj) { const f32x4 v0 = acc[ai][bj][m][0] * sc, v1 = acc[ai][bj][m][1] * sc;
                        u32x4 w; w.x = cvt_pk_bf16(v0[0], v0[1]); w.y = cvt_pk_bf16(v0[2], v0[3]); w.z = cvt_pk_bf16(v1[0], v1[1]); w.w = cvt_pk_bf16(v1[2], v1[3]);
                        *(u32x4*)(rowp + bj * HALF) = w; } }
        } else {
#pragma unroll
            for (int ai = 0; ai < 2; ++ai)
#pragma unroll
                for (int m = 0; m < 4; ++m) { const int row = row0 + ai * HALF + m * 16; const int b = row >> 12, s = row & 4095;
                    const int sp = (s & ~12) | ((s & 4) << 1) | ((s & 8) >> 1);
#pragma unroll
                    for (int bj = 0; bj < 2; ++bj)
#pragma unroll
                        for (int n = 0; n < 2; ++n)
#pragma unroll
                            for (int i = 0; i < 4; ++i) { const int c = colt + bj * HALF + wc * 32 + 8 * fq + 4 * n + i; const int hd = c >> 7, d = c & 127;
                                VT[(size_t)((b * 8 + hd) * 128 + d) * 4096 + sp] = (bf16_t)(cvt_pk_bf16(acc[ai][bj][m][n][i], 0.f) & 0xffffu); } }
        }
    }
};
struct EpiOutProjF32 {
    static constexpr bool PERM = false, AFTER_DRAIN = false, MIDK = true;
    float* O; int ldc; PG8_LAS unsigned char* ldsb;
    __device__ __forceinline__ void midk(f32x4 (&acc)[2][2][4][2], const Unit& u, int wr, int wc, int fr, int fq, PG8_LAS unsigned char* lds) const {
        const PG8_LAS f32x2* RS = (const PG8_LAS f32x2*)(lds + ::RS_OFF);
#pragma unroll
        for (int ai = 0; ai < 2; ++ai)
#pragma unroll
            for (int m = 0; m < 4; ++m) { const float f = RS[ai * HALF + wr * 64 + m * 16 + fr].x;
#pragma unroll
                for (int bj = 0; bj < 2; ++bj)
#pragma unroll
                    for (int n = 0; n < 2; ++n) acc[ai][bj][m][n] *= f; }
    }
    __device__ __forceinline__ void operator()(const f32x4 (&acc)[2][2][4][2], const Unit& u, int wr, int wc, int fr, int fq) const {
        const PG8_LAS f32x2* RS = (const PG8_LAS f32x2*)(ldsb + ::RS_OFF);
        const int col0 = u.pn * BM + wc * 32 + 4 * fq;
#pragma unroll
        for (int ai = 0; ai < 2; ++ai)
#pragma unroll
            for (int m = 0; m < 4; ++m) { const int r = ai * HALF + wr * 64 + m * 16 + fr; const float f = RS[r].y; float* rowp = O + (size_t)(u.pm * BM + r) * ldc + col0;
#pragma unroll
                for (int bj = 0; bj < 2; ++bj)
#pragma unroll
                    for (int n = 0; n < 2; ++n) *(f32x4*)(rowp + bj * HALF + n * 16) = acc[ai][bj][m][n] * f; }
    }
};
struct EpiF32 {
    static constexpr bool PERM = false, AFTER_DRAIN = false, MIDK = false;
    float* O; int ldc;
    __device__ __forceinline__ void operator()(const f32x4 (&acc)[2][2][4][2], const Unit& u, int wr, int wc, int fr, int fq) const {
        const int col0 = u.pn * BM + wc * 32 + 4 * fq;
#pragma unroll
        for (int ai = 0; ai < 2; ++ai)
#pragma unroll
            for (int m = 0; m < 4; ++m) { const int r = ai * HALF + wr * 64 + m * 16 + fr; float* rowp = O + (size_t)(u.pm * BM + r) * ldc + col0;
#pragma unroll
                for (int bj = 0; bj < 2; ++bj)
#pragma unroll
                    for (int n = 0; n < 2; ++n) *(f32x4*)(rowp + bj * HALF + n * 16) = acc[ai][bj][m][n]; }
    }
};
struct EpiSwiGLU {
    static constexpr bool PERM = true, AFTER_DRAIN = false, MIDK = false;
    bf16_t* H;
    __device__ __forceinline__ void operator()(const f32x4 (&acc)[2][2][4][2], const Unit& u, int wr, int wc, int fr, int fq) const {
        const int row0 = u.pm * BM + wr * 64 + fr, col0 = u.pn * HALF + wc * 32 + 8 * fq;
#pragma unroll
        for (int ai = 0; ai < 2; ++ai)
#pragma unroll
            for (int m = 0; m < 4; ++m) { bf16_t* rowp = H + (size_t)(row0 + ai * HALF + m * 16) * FF + col0;
                float h[8];
#pragma unroll
                for (int n = 0; n < 2; ++n)
#pragma unroll
                    for (int i = 0; i < 4; ++i) { const float g = acc[ai][0][m][n][i], up = acc[ai][1][m][n][i];
                        const float e = __builtin_amdgcn_exp2f(-1.4426950408889634f * g); h[4 * n + i] = g * __builtin_amdgcn_rcpf(1.0f + e) * up; }
                u32x4 w; w.x = cvt_pk_bf16(h[0], h[1]); w.y = cvt_pk_bf16(h[2], h[3]); w.z = cvt_pk_bf16(h[4], h[5]); w.w = cvt_pk_bf16(h[6], h[7]);
                *(u32x4*)rowp = w; }
    }
};
}

struct Frame {
    LAS unsigned char* lds;
    volatile LAS unsigned* MISC;
    gu32* ctl;
    int tid, lane, wave, vcu, G;
    const float* x; float* out;
    const float *g_premix, *g_postmix, *g_preffn, *g_postffn, *w_in, *conv_w, *conv_b, *w_rg, *b_rg, *w_ig, *b_ig, *lam, *g_attn, *g_lru, *w_out, *w_gate, *w_up, *w_down;
    bf16 *WIN, *WOUT, *WGU, *WDN, *WRG, *WIG;
    bf16 *XN, *Q, *K, *VT, *XL, *GL, *Y, *H;
    float *SSQA, *SSQL, *XCH, *MBUF, *FBUF, *ATMP;
    unsigned char* ws;
};

__device__ __forceinline__ float wave_sum(float v) {
#pragma unroll
    for (int o = 1; o < 64; o <<= 1) v += __shfl_xor(v, o);
    return v;
}

__device__ __forceinline__ void p0_transpose_item(const float* W, int ldw, bf16* WT, int ldt, int trow0, const float* kscale, LAS float* scr, int k0, int n0, int lane) {
#pragma unroll 8
    for (int i = 0; i < 32; ++i) { const int kk = 2 * i + (lane >> 5); scr[kk * 33 + (lane & 31)] = W[(size_t)(k0 + kk) * ldw + n0 + (lane & 31)]; }
    LDS_WAIT(); asm volatile("" ::: "memory");
    const int c = lane & 7;
    float ks[8];
#pragma unroll
    for (int q = 0; q < 8; ++q) ks[q] = kscale ? kscale[8 * c + q] : 1.f;
#pragma unroll
    for (int j = 0; j < 4; ++j) { const int n = (lane >> 3) + 8 * j; const LAS float* s = scr + (8 * c) * 33 + n;
        v4u o; o.x = pk2(s[0 * 33] * ks[0], s[1 * 33] * ks[1]); o.y = pk2(s[2 * 33] * ks[2], s[3 * 33] * ks[3]); o.z = pk2(s[4 * 33] * ks[4], s[5 * 33] * ks[5]); o.w = pk2(s[6 * 33] * ks[6], s[7 * 33] * ks[7]);
        *(GAS v4u*)(WT + (size_t)(trow0 + n) * ldt + k0 + 8 * c) = o; }
    LDS_WAIT(); asm volatile("" ::: "memory");
}
__device__ __forceinline__ void rms_row_to_bf16(int lane, const float* xrow, const float* g, bf16* orow) {
    const GAS f32x4* xr = (const GAS f32x4*)xrow + lane;
    f32x4 v[8]; float s = 0.f;
#pragma unroll
    for (int j = 0; j < 8; ++j) { v[j] = xr[64 * j]; s += (v[j].x * v[j].x + v[j].y * v[j].y) + (v[j].z * v[j].z + v[j].w * v[j].w); }
    const float rstd = 1.f / sqrtf(wave_sum(s) * (1.f / D) + RMS_EPS);
    GAS v2u* o8 = (GAS v2u*)orow + lane;
#pragma unroll
    for (int j = 0; j < 8; ++j) { const f32x4 gg = ((const GAS f32x4*)g)[64 * j + lane]; v2u w; w.x = pk2(v[j].x * rstd * gg.x, v[j].y * rstd * gg.y); w.y = pk2(v[j].z * rstd * gg.z, v[j].w * rstd * gg.w); o8[64 * j] = w; }
}
__device__ __forceinline__ void p0_prologue(Frame& F) {
    LAS float* scr = (LAS float*)(F.lds + RING_OFF + F.wave * 16384);
    const int gw = F.vcu * NWAVES + F.wave, NGW = F.G * NWAVES;
    constexpr int I_IN = (D / 64) * (INW / 32), I_OUT = (D / 64) * (D / 32), I_G = (D / 64) * (FF / 32), I_DN = (FF / 64) * (D / 32), I_LG = 8 * 2 * 4;
    constexpr int NITEMS = I_IN + I_OUT + 2 * I_G + I_DN + 2 * I_LG;
    for (int it = gw; it < NITEMS; it += NGW) {
        int r = it;
        if (r < I_IN) { const int kb = r / (INW / 32), nb = r % (INW / 32); p0_transpose_item(F.w_in, INW, F.WIN, D, 32 * nb, nullptr, scr, 64 * kb, 32 * nb, F.lane); continue; } r -= I_IN;
        if (r < I_OUT) { const int kb = r / (D / 32), nb = r % (D / 32); const int k0 = 64 * kb; const float* ks = (k0 < AW) ? F.g_attn + k0 : F.g_lru + (k0 - AW);
            p0_transpose_item(F.w_out, D, F.WOUT, D, 32 * nb, ks, scr, k0, 32 * nb, F.lane); continue; } r -= I_OUT;
        if (r < I_G) { const int kb = r / (FF / 32), nb = r % (FF / 32); const int n0 = 32 * nb; p0_transpose_item(F.w_gate, FF, F.WGU, D, (n0 >> 7) * 256 + (n0 & 127), nullptr, scr, 64 * kb, n0, F.lane); continue; } r -= I_G;
        if (r < I_G) { const int kb = r / (FF / 32), nb = r % (FF / 32); const int n0 = 32 * nb; p0_transpose_item(F.w_up, FF, F.WGU, D, (n0 >> 7) * 256 + 128 + (n0 & 127), nullptr, scr, 64 * kb, n0, F.lane); continue; } r -= I_G;
        if (r < I_DN) { const int kb = r / (D / 32), nb = r % (D / 32); p0_transpose_item(F.w_down, D, F.WDN, FF, 32 * nb, nullptr, scr, 64 * kb, 32 * nb, F.lane); continue; } r -= I_DN;
        if (r < I_LG) { const int blk = r >> 3, kb = (r >> 2) & 1, nb = r & 3; p0_transpose_item(F.w_rg + blk * 16384, 128, F.WRG + blk * 16384, 128, 32 * nb, nullptr, scr, 64 * kb, 32 * nb, F.lane); continue; } r -= I_LG;
        { const int blk = r >> 3, kb = (r >> 2) & 1, nb = r & 3; p0_transpose_item(F.w_ig + blk * 16384, 128, F.WIG + blk * 16384, 128, 32 * nb, nullptr, scr, 64 * kb, 32 * nb, F.lane); }
    }
    for (int m = gw; m < M; m += NGW) rms_row_to_bf16(F.lane, F.x + (size_t)m * D, F.g_premix, F.XN + (size_t)m * D);
    { GAS v4u* z = (GAS v4u*)(F.ws + WS_LAGG); const int gt = F.vcu * NWAVES * 64 + F.tid, NGT = F.G * NWAVES * 64;
      for (int i = gt; i < (int)(2 * MiB / 16); i += NGT) z[i] = (v4u){0u, 0u, 0u, 0u}; }
}

__device__ __forceinline__ float softplus2(float z2) {
    return fmaxf(z2, 0.f) + __builtin_amdgcn_logf(1.0f + __builtin_amdgcn_exp2f(-fabsf(z2)));
}
__device__ __forceinline__ void p2_attn_naive(Frame& F) {
    const int gw = F.vcu * NWAVES + F.wave, NGW = F.G * NWAVES, lane = F.lane;
    for (int qi = gw; qi < M * NH; qi += NGW) {
        const int t = qi >> 4, bh = qi & 15, b = bh >> 3, h = bh & 7;
        const size_t row = (size_t)b * SEQ + t;
        const unsigned qw = *(const GAS unsigned*)(F.Q + row * 1024 + h * 128 + 2 * lane);
        const float q0 = bflo(qw), q1 = bfhi(qw);
        float run = 0.f, o0 = 0.f, o1 = 0.f;
        const bf16* Kp = F.K + (size_t)b * SEQ * 1024 + h * 128 + 2 * lane;
        const bf16* Vp = F.VT + (size_t)(bh * 128 + 2 * lane) * 4096;
        for (int s = t - 1; s >= 0; --s) {
            const unsigned kw = *(const GAS unsigned*)(Kp + (size_t)s * 1024);
            const float z2 = wave_sum(q0 * bflo(kw) + q1 * bfhi(kw));
            const float L = -softplus2(z2);
            const float w = __builtin_amdgcn_exp2f(z2 + L + run);
            run += L;
            const int sp = (s & ~12) | ((s & 4) << 1) | ((s & 8) >> 1);
            o0 += w * bf2f(Vp[sp]); o1 += w * bf2f(Vp[4096 + sp]);
        }
        *(GAS unsigned*)(F.Y + row * 2048 + h * 128 + 2 * lane) = pk2(o0, o1);
        const float ss = wave_sum(o0 * o0 + o1 * o1);
        if (lane == 0) F.SSQA[row * 8 + h] = ss;
    }
}
__device__ __forceinline__ float gelu_tanh(float g) {
    const float u = 0.7978845608028654f * (g + 0.044715f * g * g * g);
    const float e = __builtin_amdgcn_exp2f(-2.0f * 1.4426950408889634f * fabsf(u));
    const float th = (1.0f - e) / (1.0f + e);
    return 0.5f * g * (1.0f + (u < 0.f ? -th : th));
}
__device__ __forceinline__ void p2_lru_gates_naive(Frame& F) {
    LAS float* xc = (LAS float*)(F.lds + RING_OFF);
    float* BT = F.out;
    for (int row = F.vcu; row < M; row += F.G) {
        const int t = row & (SEQ - 1);
#pragma unroll
        for (int j = 0; j < 2; ++j) { const int ch = F.tid + 512 * j; float a = F.conv_b[ch];
#pragma unroll
            for (int k = 0; k < 4; ++k) { const int tt = t - 3 + k; if (tt >= 0) a += F.conv_w[k * LW + ch] * bf2f(F.XL[(size_t)(row - 3 + k) * 1024 + ch]); }
            xc[ch] = a; }
        __syncthreads();
#pragma unroll
        for (int j = 0; j < 2; ++j) { const int ch = F.tid + 512 * j, blk = ch >> 7, d = ch & 127;
            float rr = F.b_rg[ch], ii = F.b_ig[ch];
            const float* wr_ = F.w_rg + blk * 16384 + d; const float* wi_ = F.w_ig + blk * 16384 + d; const LAS float* xb = xc + blk * 128;
            for (int c = 0; c < 128; ++c) { const float xv = xb[c]; rr += xv * wr_[c * 128]; ii += xv * wi_[c * 128]; }
            const float r = 1.0f / (1.0f + expf(-rr)), i = 1.0f / (1.0f + expf(-ii));
            const float lam = F.lam[ch]; const float lsl = -(fmaxf(-lam, 0.f) + log1pf(expf(-fabsf(lam))));
            const float log_a = 8.0f * r * lsl; const float a = expf(log_a); const float mult = sqrtf(-expm1f(2.0f * log_a));
            F.ATMP[(size_t)row * 1024 + ch] = a; BT[(size_t)row * 1024 + ch] = mult * (i * xc[ch]); }
        __syncthreads();
    }
}
__device__ __forceinline__ void p2_lru_scan_naive(Frame& F) {
    const int gt = blockIdx.x * (NWAVES * 64) + F.tid;
    const float* BT = F.out;
    if (gt < BATCH * LW) { const int b = gt >> 10, ch = gt & 1023; float h = 0.f;
        for (int t = 0; t < SEQ; ++t) { const size_t row = (size_t)b * SEQ + t;
            h = F.ATMP[row * 1024 + ch] * h + BT[row * 1024 + ch];
            const float y = h * gelu_tanh(bf2f(F.GL[row * 1024 + ch]));
            F.Y[row * 2048 + 1024 + ch] = (bf16)f2bf(y); } }
}
__device__ __forceinline__ void p2_lru_ssq_naive(Frame& F) {
    const int gw = F.vcu * NWAVES + F.wave, NGW = F.G * NWAVES, lane = F.lane;
    for (int row = gw; row < M; row += NGW) { const GAS v4u* p = (const GAS v4u*)(F.Y + (size_t)row * 2048 + 1024 + 16 * lane);
        const v4u a = p[0], b = p[1]; float s = 0.f;
#pragma unroll
        for (int q = 0; q < 4; ++q) { const float x0 = bflo(a[q]), x1 = bfhi(a[q]), x2 = bflo(b[q]), x3 = bfhi(b[q]); s += (x0 * x0 + x1 * x1) + (x2 * x2 + x3 * x3); }
        s += __shfl_xor(s, 1); s += __shfl_xor(s, 2); s += __shfl_xor(s, 4);
        if ((lane & 7) == 0) F.SSQL[(size_t)row * 8 + (lane >> 3)] = s; }
}
__device__ __forceinline__ void p3b_rows(Frame& F) {
    const int gw = F.vcu * NWAVES + F.wave, NGW = F.G * NWAVES, lane = F.lane;
    for (int row = gw; row < M; row += NGW) {
        const GAS f32x4* mr = (const GAS f32x4*)(F.MBUF + (size_t)row * D) + lane; const GAS f32x4* xr = (const GAS f32x4*)(F.x + (size_t)row * D) + lane;
        f32x4 v[8]; float s = 0.f;
#pragma unroll
        for (int j = 0; j < 8; ++j) { v[j] = mr[64 * j]; s += (v[j].x * v[j].x + v[j].y * v[j].y) + (v[j].z * v[j].z + v[j].w * v[j].w); }
        const float rstd = 1.f / sqrtf(wave_sum(s) * (1.f / D) + RMS_EPS); float s2 = 0.f;
        GAS f32x4* orow = (GAS f32x4*)(F.out + (size_t)row * D) + lane;
#pragma unroll
        for (int j = 0; j < 8; ++j) { const f32x4 gg = ((const GAS f32x4*)F.g_postmix)[64 * j + lane]; v[j] = xr[64 * j] + v[j] * rstd * gg; orow[64 * j] = v[j];
            s2 += (v[j].x * v[j].x + v[j].y * v[j].y) + (v[j].z * v[j].z + v[j].w * v[j].w); }
        const float rstd2 = 1.f / sqrtf(wave_sum(s2) * (1.f / D) + RMS_EPS);
        GAS v2u* o8 = (GAS v2u*)(F.XN + (size_t)row * D) + lane;
#pragma unroll
        for (int j = 0; j < 8; ++j) { const f32x4 gg = ((const GAS f32x4*)F.g_preffn)[64 * j + lane]; v2u w; w.x = pk2(v[j].x * rstd2 * gg.x, v[j].y * rstd2 * gg.y); w.y = pk2(v[j].z * rstd2 * gg.z, v[j].w * rstd2 * gg.w); o8[64 * j] = w; }
    }
}
__device__ __forceinline__ void p5b_rows(Frame& F) {
    const int gw = F.vcu * NWAVES + F.wave, NGW = F.G * NWAVES, lane = F.lane;
    for (int row = gw; row < M; row += NGW) {
        const GAS f32x4* fr_ = (const GAS f32x4*)(F.FBUF + (size_t)row * D) + lane;
        f32x4 v[8]; float s = 0.f;
#pragma unroll
        for (int j = 0; j < 8; ++j) { v[j] = fr_[64 * j]; s += (v[j].x * v[j].x + v[j].y * v[j].y) + (v[j].z * v[j].z + v[j].w * v[j].w); }
        const float rstd = 1.f / sqrtf(wave_sum(s) * (1.f / D) + RMS_EPS);
        GAS f32x4* orow = (GAS f32x4*)(F.out + (size_t)row * D) + lane;
#pragma unroll
        for (int j = 0; j < 8; ++j) { const f32x4 gg = ((const GAS f32x4*)F.g_postffn)[64 * j + lane]; orow[64 * j] = orow[64 * j] + v[j] * rstd * gg; }
    }
}
__device__ __forceinline__ void p3_row_table(Frame& F, int pm) {
    LAS f32x2* RS = (LAS f32x2*)(F.lds + RS_OFF);
    if (F.tid < 256) { const size_t row = (size_t)pm * 256 + F.tid; const GAS f32x4* a = (const GAS f32x4*)(F.SSQA + row * 8); const GAS f32x4* l = (const GAS f32x4*)(F.SSQL + row * 8);
        const f32x4 a0 = a[0], a1 = a[1], l0 = l[0], l1 = l[1];
        const float sa = ((a0.x + a0.y) + (a0.z + a0.w)) + ((a1.x + a1.y) + (a1.z + a1.w)), sl = ((l0.x + l0.y) + (l0.z + l0.w)) + ((l1.x + l1.y) + (l1.z + l1.w));
        const float ra = 1.f / sqrtf(sa * (1.f / AW) + RMS_EPS), rl = 1.f / sqrtf(sl * (1.f / LW) + RMS_EPS);
        RS[F.tid] = (f32x2){ra / rl, rl}; }
    __syncthreads();
}

constexpr int PH_P0 = 0, PH_P1 = 1, PH_P2A = 2, PH_P2B = 3, PH_P2C = 4, PH_P3 = 5, PH_P3B = 6, PH_P4 = 7, PH_P5 = 8, PH_P5B = 9, N_PHASES = 10;
struct Args { const float* in[19]; float* out; unsigned char* ws; int ph_lo, ph_hi, li, pad; };
__global__ void __launch_bounds__(NWAVES * 64, 2) hymba_fwd(Args args) {
    extern __shared__ __attribute__((aligned(16))) unsigned char lds[];
    Frame F;
    F.lds = (LAS unsigned char*)lds;
    F.MISC = (volatile LAS unsigned*)(F.lds + MISC_OFF);
    F.tid = threadIdx.x; F.lane = F.tid & 63; F.wave = __builtin_amdgcn_readfirstlane(F.tid >> 6);
    F.G = gridDim.x; { const int bx = blockIdx.x; F.vcu = (F.G % 8 == 0) ? (bx % 8) * (F.G / 8) + bx / 8 : bx; }
    unsigned char* ws = args.ws; F.ws = ws;
    F.ctl = (gu32*)(ws + WS_CTL);
    F.x = args.in[0]; F.g_premix = args.in[1]; F.g_postmix = args.in[2]; F.g_preffn = args.in[3]; F.g_postffn = args.in[4]; F.w_in = args.in[5]; F.conv_w = args.in[6]; F.conv_b = args.in[7];
    F.w_rg = args.in[8]; F.b_rg = args.in[9]; F.w_ig = args.in[10]; F.b_ig = args.in[11]; F.lam = args.in[12]; F.g_attn = args.in[13]; F.g_lru = args.in[14]; F.w_out = args.in[15];
    F.w_gate = args.in[16]; F.w_up = args.in[17]; F.w_down = args.in[18]; F.out = args.out;
    F.WIN = (bf16*)(ws + WS_WIN); F.WOUT = (bf16*)(ws + WS_WOUT); F.WGU = (bf16*)(ws + WS_WGU); F.WDN = (bf16*)(ws + WS_WDN); F.WRG = (bf16*)(ws + WS_WRG); F.WIG = (bf16*)(ws + WS_WIG);
    F.XN = (bf16*)(ws + WS_XN); F.Q = (bf16*)(ws + WS_Q); F.K = (bf16*)(ws + WS_K); F.VT = (bf16*)(ws + WS_VT); F.XL = (bf16*)(ws + WS_XL); F.GL = (bf16*)(ws + WS_GL); F.Y = (bf16*)(ws + WS_Y); F.H = (bf16*)(ws + WS_H);
    F.SSQA = (float*)(ws + WS_SSQA); F.SSQL = (float*)(ws + WS_SSQL); F.XCH = (float*)(ws + WS_XCH); F.MBUF = (float*)(ws + WS_MBUF); F.FBUF = (float*)(ws + WS_FBUF); F.ATMP = (float*)(ws + WS_ATMP);
    for (int u = F.tid; u < (LDS_BYTES - LDSCTL_OFF) / 4; u += NWAVES * 64) ((LAS unsigned*)(F.lds + LDSCTL_OFF))[u] = 0u;
    __syncthreads();
    const bool one_launch = (MK_N_LAUNCHES == 1);
    XcdBarrier bar; bar.bar = (unsigned*)(F.ctl + CW_BAR); bar.x = 0; bar.st = nullptr;
    if (one_launch) bar = xcd_barrier_post((unsigned*)(F.ctl + CW_BAR), F.MISC + 8);
    const int lo = args.ph_lo, hi = args.ph_hi;
#define IN(k) (lo <= (k) && (k) < hi)
#define SEAM(k) do { if (IN(k) && IN((k) + 1)) xcd_barrier(bar); } while (0)

    if (IN(PH_P0)) { p0_prologue(F); } SEAM(PH_P0);
    if (IN(PH_P1)) {
        pg8::Gemm g{F.XN, F.WIN, M, INW, D}; pg8::StaticOrder S; S.init(M, INW, F.G, (int)blockIdx.x);
        pg8::EpiInProj E{F.Q, F.K, F.VT, F.XL, F.GL};
        pg8::gemm_phase<pg8::EpiInProj, pg8::StaticOrder, true, true>(F.lds + RING_OFF, g, S, E);
    } SEAM(PH_P1);
    if (IN(PH_P2A)) { p2_lru_gates_naive(F); p2_attn_naive(F); } SEAM(PH_P2A);
    if (IN(PH_P2B)) { p2_lru_scan_naive(F); } SEAM(PH_P2B);
    if (IN(PH_P2C)) { p2_lru_ssq_naive(F); } SEAM(PH_P2C);
    if (IN(PH_P3)) {
        pg8::Gemm g{F.Y, F.WOUT, M, D, D}; pg8::StaticOrder S; S.init(M, D, F.G, (int)blockIdx.x);
        pg8::Unit u0; if (S.next(0, u0)) p3_row_table(F, u0.pm); else __syncthreads();
        pg8::EpiOutProjF32 E{F.MBUF, D, F.lds};
        pg8::gemm_phase<pg8::EpiOutProjF32, pg8::StaticOrder, false, true>(F.lds + RING_OFF, g, S, E);
    } SEAM(PH_P3);
    if (IN(PH_P3B)) { p3b_rows(F); } SEAM(PH_P3B);
    if (IN(PH_P4)) {
        pg8::Gemm g{F.XN, F.WGU, M, GUW, D}; pg8::StaticOrder S; S.init(M, GUW, F.G, (int)blockIdx.x);
        pg8::EpiSwiGLU E{F.H};
        pg8::gemm_phase<pg8::EpiSwiGLU, pg8::StaticOrder, true, true>(F.lds + RING_OFF, g, S, E);
    } SEAM(PH_P4);
    if (IN(PH_P5)) {
        pg8::Gemm g{F.H, F.WDN, M, D, FF}; pg8::StaticOrder S; S.init(M, D, F.G, (int)blockIdx.x);
        pg8::EpiF32 E{F.FBUF, D};
        pg8::gemm_phase<pg8::EpiF32, pg8::StaticOrder, false, true>(F.lds + RING_OFF, g, S, E);
    } SEAM(PH_P5);
    if (IN(PH_P5B)) { p5b_rows(F); }
#undef IN
#undef SEAM
}

extern "C" void kernel_launch(void* const* d_in, const int* in_sizes, int n_in, void* d_out, int out_size, void* d_ws, size_t ws_size, hipStream_t stream) {
    static int grid = 0;
    if (grid == 0) {
        if (n_in != 19 || in_sizes[0] != M * D || out_size != M * D || ws_size < WS_END) { fprintf(stderr, "kernel_launch: unexpected shapes (n_in %d, in0 %d, out %d, ws %zu); nothing launched\n", n_in, n_in > 0 ? in_sizes[0] : -1, out_size, ws_size); grid = -1; return; }
        int dev = 0, cus = 0, per_cu = 0;
        if (hipGetDevice(&dev) != hipSuccess || hipDeviceGetAttribute(&cus, hipDeviceAttributeMultiprocessorCount, dev) != hipSuccess) { grid = -1; return; }
        if (hipFuncSetAttribute((const void*)hymba_fwd, hipFuncAttributeMaxDynamicSharedMemorySize, LDS_BYTES) != hipSuccess) { fprintf(stderr, "kernel_launch: hipFuncSetAttribute failed\n"); grid = -1; return; }
        if (hipOccupancyMaxActiveBlocksPerMultiprocessor(&per_cu, (const void*)hymba_fwd, NWAVES * 64, LDS_BYTES) != hipSuccess || per_cu < 1)
            fprintf(stderr, "kernel_launch: note: occupancy query reports %d workgroups per CU\n", per_cu);
        (void)hipGetLastError();
        grid = cus;
    }
    if (grid < 0) return;
    if (hipMemsetAsync((char*)d_ws + WS_CTL, 0, CTL_ZERO_BYTES, stream) != hipSuccess) { fprintf(stderr, "kernel_launch: hipMemsetAsync failed\n"); return; }
    Args a{};
    for (int i = 0; i < 19; ++i) a.in[i] = (const float*)d_in[i];
    a.out = (float*)d_out; a.ws = (unsigned char*)d_ws;
#if MK_N_LAUNCHES == 1
    a.ph_lo = 0; a.ph_hi = N_PHASES; a.li = 0;
    hipLaunchKernelGGL(hymba_fwd, dim3(grid), dim3(NWAVES * 64), LDS_BYTES, stream, a);
#else
    for (int li = 0; li < N_PHASES; ++li) { a.ph_lo = li; a.ph_hi = li + 1; a.li = li;
        hipLaunchKernelGGL(hymba_fwd, dim3(grid), dim3(NWAVES * 64), LDS_BYTES, stream, a); }
#endif
    const hipError_t le = hipPeekAtLastError();
    if (le != hipSuccess) fprintf(stderr, "kernel_launch: launch failed: %s\n", hipGetErrorName(le));
}
```

```cpp
#include <hip/hip_runtime.h>
#include <cstdio>
#include <cstdint>
#define MK_N_LAUNCHES 1
namespace pg8 {
#define PG8_LAS __attribute__((address_space(3)))
typedef unsigned short bf16_t;
typedef short bf16x8 __attribute__((ext_vector_type(8)));
typedef float f32x4 __attribute__((ext_vector_type(4)));
typedef unsigned u32x4 __attribute__((ext_vector_type(4)));
constexpr int BM = 256, BK = 64, HALF = 128, HTB = HALF * BK * 2  , STAGE_BYTES = 8 * HTB, NXCD = 8, WGM = 8;

__host__ __device__ __forceinline__ int lds_byte(int r, int c) { const int st = (r >> 4) * 2 + (c >> 5), rr = r & 15, cc = c & 31, ob = rr * 64 + cc * 2; return st * 1024 + (ob ^ (((ob >> 9) & 1) << 5)); }
__host__ __device__ __forceinline__ void stage_rc(int b, int& R, int& C) { const int st = b / 1024, sb = b % 1024, swz = sb ^ (((sb >> 9) & 1) << 5); R = (st >> 1) * 16 + swz / 64; C = (st & 1) * 32 + (swz % 64) / 2; }
__host__ __device__ __forceinline__ int perm32(int rho) { const int n = rho >> 4, i = rho & 15; return 8 * (i >> 2) + 4 * n + (i & 3); }

struct Unit { int pm, pn; };
struct Gemm { const bf16_t* A; const bf16_t* Bt; int M, N, K; };

struct StaticOrder {
    int nM, nN, nwg, G, c;
    __host__ __device__ void init(int M, int N, int G_, int c_) { nM = M / BM; nN = N / BM; nwg = nM * nN; G = G_; c = c_; }
    __host__ __device__ bool next(int i, Unit& u) const {
        const long L = (long)i * G + c; if (L >= nwg) return false;
        int wgid = (int)L; { const int q = nwg / NXCD, r = nwg % NXCD, xcd = wgid % NXCD, off = wgid / NXCD; wgid = (xcd < r ? xcd * (q + 1) : r * (q + 1) + (xcd - r) * q) + off; }
        const int nig = WGM * nN, gid = wgid / nig, fm = gid * WGM, gsz = (nM - fm) < WGM ? (nM - fm) : WGM;
        u.pm = fm + ((wgid % nig) % gsz); u.pn = (wgid % nig) / gsz; return true;
    }
    __device__ __forceinline__ void a_ready(const Unit&) const {}
    __device__ __forceinline__ void done(const Unit&) const {}
};

__device__ __forceinline__ unsigned cvt_pk_bf16(float lo, float hi) { unsigned r; asm volatile("v_cvt_pk_bf16_f32 %0, %1, %2" : "=v"(r) : "v"(lo), "v"(hi)); return r; }
typedef float f32x2 __attribute__((ext_vector_type(2)));
__device__ __forceinline__ f32x2 gelu_pk(f32x2 v) {
    const f32x2 av = __builtin_elementwise_abs(v), d = av * 0.2316418882f + 1.0f;
    f32x2 t; t.x = __builtin_amdgcn_rcpf(d.x); t.y = __builtin_amdgcn_rcpf(d.y);
    f32x2 q = t * 0.5307027145f + (-0.7265760135f); q = q * t + 0.7107068705f; q = q * t + (-0.142248368f); q = q * t + 0.127414796f; q = q * t;
    const f32x2 s = (v * v) * (-0.72134752044f);
    f32x2 e; e.x = __builtin_amdgcn_exp2f(s.x); e.y = __builtin_amdgcn_exp2f(s.y);
    const f32x2 m = v * (q * e), r = v - m;
    f32x2 o; o.x = v.x < 0.f ? m.x : r.x; o.y = v.y < 0.f ? m.y : r.y; return o;
}

template <int ACT  > struct EpiBf16 {
    static constexpr bool PERM = true, AFTER_DRAIN = false; static_assert(ACT == 0 || ACT == 1, "EpiBf16: ACT is 0 (none) or 1 (gelu_pk)");
    bf16_t* O; int ldc; const float* bias; int split_cols; size_t split_stride; float scale0;
    __device__ __forceinline__ void operator()(const f32x4 (&acc)[2][2][4][2], const Unit& u, int wr, int wc, int fr, int fq) const {
        const int row0 = u.pm * BM + wr * 64 + fr; int colt = u.pn * BM; bf16_t* base = O;
        float sc = 1.f; if (split_cols) { const int t = colt / split_cols; base += (size_t)t * split_stride; colt -= t * split_cols; if (t == 0) sc = scale0; }
        const int col0 = colt + wc * 32 + 8 * fq, bcol0 = u.pn * BM + wc * 32 + 8 * fq;
        f32x4 bv[2][2];
#pragma unroll
        for (int bj = 0; bj < 2; ++bj)
#pragma unroll
            for (int n = 0; n < 2; ++n) bv[bj][n] = bias ? *(const f32x4*)(bias + bcol0 + bj * HALF + 4 * n) : (f32x4){0.f, 0.f, 0.f, 0.f};
#pragma unroll
        for (int ai = 0; ai < 2; ++ai)
#pragma unroll
            for (int m = 0; m < 4; ++m) { bf16_t* rowp = base + (size_t)(row0 + ai * HALF + m * 16) * ldc + col0;
#pragma unroll
                for (int bj = 0; bj < 2; ++bj) { f32x4 v0 = acc[ai][bj][m][0] + bv[bj][0], v1 = acc[ai][bj][m][1] + bv[bj][1];
                    if (ACT == 1) { f32x2 a = gelu_pk((f32x2){v0[0], v0[1]}), b = gelu_pk((f32x2){v0[2], v0[3]}), c = gelu_pk((f32x2){v1[0], v1[1]}), d = gelu_pk((f32x2){v1[2], v1[3]});
                        v0 = (f32x4){a.x, a.y, b.x, b.y}; v1 = (f32x4){c.x, c.y, d.x, d.y}; }
                    v0 = v0 * sc; v1 = v1 * sc; u32x4 w; w.x = cvt_pk_bf16(v0[0], v0[1]); w.y = cvt_pk_bf16(v0[2], v0[3]); w.z = cvt_pk_bf16(v1[0], v1[1]); w.w = cvt_pk_bf16(v1[2], v1[3]);
                    *(u32x4*)(rowp + bj * HALF) = w; } }
    }
};

struct PanelStats {
    unsigned* xbuf;
    unsigned* cnt;
    unsigned* tmo;
    int ntn; float eps;
    unsigned code;
    __device__ __forceinline__ bool run(const f32x4 (&v)[2][2][4][2], const Unit& u, int wr, int wc, int fr, int fq, PG8_LAS unsigned char* lds, int wid, int lane) const {
        typedef float f32x2v __attribute__((ext_vector_type(2)));
        PG8_LAS f32x2v* P = (PG8_LAS f32x2v*)lds;
        PG8_LAS f32x2v* S = (PG8_LAS f32x2v*)(lds + 8192);
        PG8_LAS unsigned* flag = (PG8_LAS unsigned*)(lds + 8192 + 2048);
#pragma unroll
        for (int ai = 0; ai < 2; ++ai)
#pragma unroll
            for (int m = 0; m < 4; ++m) {
                float s = 0.f;
#pragma unroll
                for (int bj = 0; bj < 2; ++bj)
#pragma unroll
                    for (int n = 0; n < 2; ++n) { const f32x4 x = v[ai][bj][m][n]; s += (x[0] + x[1]) + (x[2] + x[3]); }
                s += __shfl_xor(s, 16); s += __shfl_xor(s, 32);
                const float mw = s * (1.0f / 64.0f); float q = 0.f;
#pragma unroll
                for (int bj = 0; bj < 2; ++bj)
#pragma unroll
                    for (int n = 0; n < 2; ++n) { const f32x4 d = v[ai][bj][m][n] - mw; q += (d[0] * d[0] + d[1] * d[1]) + (d[2] * d[2] + d[3] * d[3]); }
                q += __shfl_xor(q, 16); q += __shfl_xor(q, 32);
                if (fq == 0) P[(ai * HALF + wr * 64 + m * 16 + fr) * 4 + wc] = (f32x2v){mw, q};
            }
        asm volatile("s_waitcnt lgkmcnt(0)" ::: "memory"); __builtin_amdgcn_s_barrier(); asm volatile("" ::: "memory");
#if defined(BROKEN_EXCHANGE_NO_WAIT)
#warning BROKEN CONTROL BUILD: the row-statistics exchange does not wait; results are wrong by design
        if (blockIdx.x >= 64) { const long long t0_ = clock64(); while (clock64() - t0_ < 60000) __builtin_amdgcn_s_sleep(8); }
#endif
        const int row = wid * 32 + (lane & 31);
        if (lane < 32) {
            const f32x2v a = P[row * 4 + 0], b = P[row * 4 + 1], c = P[row * 4 + 2], d = P[row * 4 + 3];
            const float mt = (a.x + b.x + c.x + d.x) * 0.25f;
            const float da = a.x - mt, db = b.x - mt, dc = c.x - mt, dd = d.x - mt;
            const float m2 = (a.y + b.y) + (c.y + d.y) + 64.0f * ((da * da + db * db) + (dc * dc + dd * dd));
            unsigned long long* slot = (unsigned long long*)xbuf + ((size_t)(u.pm * BM + row) * 4 + u.pn);
            __hip_atomic_store(slot, ((unsigned long long)__float_as_uint(m2) << 32) | __float_as_uint(mt), __ATOMIC_RELAXED, __HIP_MEMORY_SCOPE_AGENT);
        }
        asm volatile("s_waitcnt vmcnt(0)" ::: "memory");
        if (lane == 0) __hip_atomic_fetch_add(cnt + 64 * u.pm, 1u, __ATOMIC_RELAXED, __HIP_MEMORY_SCOPE_AGENT);
        if (wid == 0) {
            bool dead = false; const unsigned long long t0 = __builtin_amdgcn_s_memrealtime(); const unsigned want = 8u * (unsigned)ntn;
            for (;;) {
#if defined(BROKEN_EXCHANGE_NO_WAIT)
                break;
#endif
                if ((unsigned)__builtin_amdgcn_readfirstlane(__hip_atomic_load(cnt + 64 * u.pm, __ATOMIC_RELAXED, __HIP_MEMORY_SCOPE_AGENT)) >= want) break;
                if (__builtin_amdgcn_s_memrealtime() - t0 > 2000000ull) {
                    if (lane == 0) { unsigned expect = 0u; __hip_atomic_compare_exchange_strong(tmo + 1, &expect, code | (unsigned)(u.pm & 0xff), __ATOMIC_RELAXED, __ATOMIC_RELAXED, __HIP_MEMORY_SCOPE_AGENT);
                                     __hip_atomic_store(tmo, 1u, __ATOMIC_RELAXED, __HIP_MEMORY_SCOPE_AGENT); }
                    dead = true; break; }
                __builtin_amdgcn_s_sleep(2);
            }
            __builtin_amdgcn_fence(__ATOMIC_ACQUIRE, "agent");
            if (lane == 0) flag[0] = dead ? 1u : 0u;
        }
        asm volatile("s_waitcnt vmcnt(0) lgkmcnt(0)" ::: "memory"); __builtin_amdgcn_s_barrier(); asm volatile("" ::: "memory");
        const bool bad = flag[0] != 0u;
        if (lane < 32) {
            const unsigned long long* slot = (const unsigned long long*)xbuf + (size_t)(u.pm * BM + row) * 4; float mt[4], m2[4]; float ms = 0.f;
#pragma unroll
            for (int t = 0; t < 4; ++t) { if (t < ntn) { const unsigned long long w = __hip_atomic_load(slot + t, __ATOMIC_RELAXED, __HIP_MEMORY_SCOPE_AGENT); mt[t] = __uint_as_float((unsigned)w); m2[t] = __uint_as_float((unsigned)(w >> 32)); } else { mt[t] = 0.f; m2[t] = 0.f; } ms += mt[t]; }
            const float mean = ms / (float)ntn; float q = 0.f;
#pragma unroll
            for (int t = 0; t < 4; ++t) if (t < ntn) { const float dm = mt[t] - mean; q += m2[t] + 256.0f * dm * dm; }
            S[row] = (f32x2v){mean, 1.0f / sqrtf(q / (256.0f * (float)ntn) + eps)};
        }
        asm volatile("s_waitcnt lgkmcnt(0)" ::: "memory"); __builtin_amdgcn_s_barrier(); asm volatile("" ::: "memory");
        return bad;
    }
};
struct EpiLnRes {
    static constexpr bool PERM = false, AFTER_DRAIN = true;
    const float* base; float* out; int ldc; const float* bias; PanelStats st; unsigned poison;
    __device__ __forceinline__ void fused(f32x4 (&acc)[2][2][4][2], const Unit& u, int wr, int wc, int fr, int fq, PG8_LAS unsigned char* lds, int wid, int lane) const {
        typedef float f32x2v __attribute__((ext_vector_type(2)));
        const PG8_LAS f32x2v* S = (const PG8_LAS f32x2v*)(lds + 8192);
        const int col0 = u.pn * BM + wc * 32 + 4 * fq;
#pragma unroll
        for (int bj = 0; bj < 2; ++bj)
#pragma unroll
            for (int n = 0; n < 2; ++n) { const f32x4 bv = bias ? *(const f32x4*)(bias + col0 + bj * HALF + n * 16) : (f32x4){0.f, 0.f, 0.f, 0.f};
#pragma unroll
                for (int ai = 0; ai < 2; ++ai)
#pragma unroll
                    for (int m = 0; m < 4; ++m) acc[ai][bj][m][n] += bv; }
        f32x4 pre[4][2][2];
#pragma unroll
        for (int m = 0; m < 4; ++m) { const size_t off = (size_t)(u.pm * BM + wr * 64 + m * 16 + fr) * ldc + col0;
#pragma unroll
            for (int bj = 0; bj < 2; ++bj)
#pragma unroll
                for (int n = 0; n < 2; ++n) pre[m][bj][n] = *(const f32x4*)(base + off + bj * HALF + n * 16); }
        const bool bad = st.run(acc, u, wr, wc, fr, fq, lds, wid, lane) || poison != 0u;
        const float qnan = __builtin_nanf("");
#pragma unroll
        for (int ai = 0; ai < 2; ++ai)
#pragma unroll
            for (int m = 0; m < 4; ++m) { const int r = ai * HALF + wr * 64 + m * 16 + fr; const f32x2v sr = S[r]; const size_t off = (size_t)(u.pm * BM + r) * ldc + col0;
#pragma unroll
                for (int bj = 0; bj < 2; ++bj)
#pragma unroll
                    for (int n = 0; n < 2; ++n) { const f32x4 bs = ai == 0 ? pre[m][bj][n] : *(const f32x4*)(base + off + bj * HALF + n * 16); f32x4 o = bs + (acc[ai][bj][m][n] - sr.x) * sr.y;
                        if (bad) o = (f32x4){qnan, qnan, qnan, qnan}; *(f32x4*)(out + off + bj * HALF + n * 16) = o; }
                if (m & 1) asm volatile("" ::: "memory"); }
    }
};
struct EpiLnResLn {
    static constexpr bool PERM = false, AFTER_DRAIN = true;
    const float* base; float* out; bf16_t* xn; int ldc; const float* bias; PanelStats st1, st2; unsigned poison;
    __device__ __forceinline__ void fused(f32x4 (&acc)[2][2][4][2], const Unit& u, int wr, int wc, int fr, int fq, PG8_LAS unsigned char* lds, int wid, int lane) const {
        typedef float f32x2v __attribute__((ext_vector_type(2))); typedef unsigned u32x2v __attribute__((ext_vector_type(2)));
        const PG8_LAS f32x2v* S = (const PG8_LAS f32x2v*)(lds + 8192);
        const int col0 = u.pn * BM + wc * 32 + 4 * fq;
#pragma unroll
        for (int bj = 0; bj < 2; ++bj)
#pragma unroll
            for (int n = 0; n < 2; ++n) { const f32x4 bv = bias ? *(const f32x4*)(bias + col0 + bj * HALF + n * 16) : (f32x4){0.f, 0.f, 0.f, 0.f};
#pragma unroll
                for (int ai = 0; ai < 2; ++ai)
#pragma unroll
                    for (int m = 0; m < 4; ++m) acc[ai][bj][m][n] += bv; }
        bool bad = st1.run(acc, u, wr, wc, fr, fq, lds, wid, lane) || poison != 0u;
        const float qnan = __builtin_nanf("");
#pragma unroll
        for (int ai = 0; ai < 2; ++ai)
#pragma unroll
            for (int m = 0; m < 4; ++m) { const int r = ai * HALF + wr * 64 + m * 16 + fr; const f32x2v sr = S[r]; const size_t off = (size_t)(u.pm * BM + r) * ldc + col0;
#pragma unroll
                for (int bj = 0; bj < 2; ++bj)
#pragma unroll
                    for (int n = 0; n < 2; ++n) { const f32x4 bs = *(const f32x4*)(base + off + bj * HALF + n * 16); acc[ai][bj][m][n] = bs + (acc[ai][bj][m][n] - sr.x) * sr.y; }
                asm volatile("" : "+v"(acc[ai][0][m][0]), "+v"(acc[ai][0][m][1]), "+v"(acc[ai][1][m][0]), "+v"(acc[ai][1][m][1]));
                if (m & 1) asm volatile("" ::: "memory"); }
        const bool bad1 = bad;
        bad = st2.run(acc, u, wr, wc, fr, fq, lds, wid, lane) || bad;
#pragma unroll
        for (int ai = 0; ai < 2; ++ai)
#pragma unroll
            for (int m = 0; m < 4; ++m) { const int r = ai * HALF + wr * 64 + m * 16 + fr; const f32x2v sr = S[r]; const size_t off = (size_t)(u.pm * BM + r) * ldc + col0;
#pragma unroll
                for (int bj = 0; bj < 2; ++bj)
#pragma unroll
                    for (int n = 0; n < 2; ++n) { const f32x4 x1 = acc[ai][bj][m][n]; *(f32x4*)(out + off + bj * HALF + n * 16) = bad1 ? (f32x4){qnan, qnan, qnan, qnan} : x1;
                        const f32x4 o = (x1 - sr.x) * sr.y; u32x2v w; w.x = cvt_pk_bf16(o[0], o[1]); w.y = cvt_pk_bf16(o[2], o[3]);
                        if (bad) { w.x = 0x7fc07fc0u; w.y = 0x7fc07fc0u; } *(u32x2v*)(xn + off + bj * HALF + n * 16) = w; }
                asm volatile("" ::: "memory"); }
    }
};

template <class Epi, class Sched, bool ALIGN_EPI = false, bool SP2 = false>
__device__ __forceinline__ void gemm_phase(PG8_LAS unsigned char* lds, const Gemm g, const Sched& S, const Epi& E) {
    const int tid = threadIdx.x, wid = __builtin_amdgcn_readfirstlane(tid >> 6), lane = tid & 63, wr = wid >> 2, wc = wid & 3, fr = lane & 15, fq = lane >> 4;
    const int K = g.K, nt = K / BK;
    unsigned voffA[2], voffB[2];
#pragma unroll
    for (int i = 0; i < 2; ++i) { int R, C; stage_rc(tid * 16 + i * 8192, R, C); const int Rb = Epi::PERM ? ((R & ~31) + perm32(R & 31)) : R;
        voffA[i] = (unsigned)(R * K + C) * 2u; voffB[i] = (unsigned)(Rb * K + C) * 2u; }
    const size_t kstep = (size_t)(BK * 2);
    const size_t hstep = (size_t)HALF * K * 2;
    const size_t tstep = 2 * hstep;
    const unsigned ldsw = (unsigned)wid * 1024u;
    const int aoff = lds_byte(wr * 64 + fr, fq * 8), boff = lds_byte(wc * 32 + fr, fq * 8);
#define PG8_SA(b, h) (((b) * 2 + (h)) * HTB)
#define PG8_SB(b, h) ((4 + (b) * 2 + (h)) * HTB)
#define PG8_STAGE(bufoff, gbase, voff) do { _Pragma("unroll") for (int _i = 0; _i < 2; ++_i) \
        __builtin_amdgcn_global_load_lds((const unsigned*)((const char*)(gbase) + (voff)[_i]), (PG8_LAS unsigned*)(lds + (bufoff) + ldsw + _i * 8192), 16, 0, 0); } while (0)
#define PG8_LDA(dst, b, h) do { _Pragma("unroll") for (int m = 0; m < 4; ++m) _Pragma("unroll") for (int k = 0; k < 2; ++k) dst[m][k] = *(const PG8_LAS bf16x8*)(lds + PG8_SA(b, h) + aoff + m * 2048 + k * 1024); } while (0)
#define PG8_LDB(dst, b, h) do { _Pragma("unroll") for (int n = 0; n < 2; ++n) _Pragma("unroll") for (int k = 0; k < 2; ++k) dst[n][k] = *(const PG8_LAS bf16x8*)(lds + PG8_SB(b, h) + boff + n * 2048 + k * 1024); } while (0)
#define PG8_MMA(ai, bj, At, Bt) do { __builtin_amdgcn_s_setprio(1); _Pragma("unroll") for (int m = 0; m < 4; ++m) _Pragma("unroll") for (int n = 0; n < 2; ++n) _Pragma("unroll") for (int k = 0; k < 2; ++k) \
        acc[ai][bj][m][n] = __builtin_amdgcn_mfma_f32_16x16x32_bf16(Bt[n][k], At[m][k], acc[ai][bj][m][n], 0, 0, 0); __builtin_amdgcn_s_setprio(0); } while (0)
#define PG8_WAIT_V(n) asm volatile("s_waitcnt vmcnt(" #n ")" ::: "memory")
#define PG8_WAIT_L(n) asm volatile("s_waitcnt lgkmcnt(" #n ")" ::: "memory")
#define PG8_BAR __builtin_amdgcn_s_barrier()
#define PG8_SCHED __builtin_amdgcn_sched_barrier(0)
    Unit cur, nxt; int ui = 0;
    if (!S.next(0, cur)) return;
    f32x4 acc[2][2][4][2];
#pragma unroll
    for (int a = 0; a < 2; ++a)
#pragma unroll
        for (int b = 0; b < 2; ++b)
#pragma unroll
            for (int m = 0; m < 4; ++m)
#pragma unroll
                for (int n = 0; n < 2; ++n) acc[a][b][m][n] = (f32x4){0.f, 0.f, 0.f, 0.f};
    bf16x8 At[4][2], B0[2][2], B1[2][2];
    const char* cA = (const char*)g.A + (size_t)cur.pm * tstep; const char* cB = (const char*)g.Bt + (size_t)cur.pn * tstep;
    S.a_ready(cur);
    if constexpr (SP2) {
        PG8_STAGE(PG8_SB(0, 0), cB, voffB); PG8_STAGE(PG8_SB(0, 1), cB + hstep, voffB); PG8_STAGE(PG8_SA(0, 0), cA, voffA); PG8_STAGE(PG8_SA(0, 1), cA + hstep, voffA);
        if (wr == 1) PG8_BAR;
        PG8_WAIT_V(2); PG8_BAR;
        PG8_STAGE(PG8_SB(1, 0), cB + kstep, voffB); PG8_STAGE(PG8_SA(1, 0), cA + kstep, voffA); PG8_STAGE(PG8_SB(1, 1), cB + hstep + kstep, voffB);
        PG8_WAIT_V(6); PG8_BAR;
    } else {
        PG8_STAGE(PG8_SB(0, 0), cB, voffB); PG8_STAGE(PG8_SA(0, 0), cA, voffA); PG8_STAGE(PG8_SB(0, 1), cB + hstep, voffB); PG8_STAGE(PG8_SA(0, 1), cA + hstep, voffA);
        if (wr == 1) PG8_BAR;
        PG8_WAIT_V(4); PG8_BAR;
        PG8_STAGE(PG8_SB(1, 0), cB + kstep, voffB); PG8_STAGE(PG8_SA(1, 0), cA + kstep, voffA); PG8_STAGE(PG8_SB(1, 1), cB + hstep + kstep, voffB);
        PG8_WAIT_V(6); PG8_BAR;
    }
    for (;;) {
        const bool has_next = S.next(ui + 1, nxt);
        const char* nA = has_next ? (const char*)g.A + (size_t)nxt.pm * tstep : cA; const char* nB = has_next ? (const char*)g.Bt + (size_t)nxt.pn * tstep : cB;
        for (int t = 0; t < nt; t += 2) {
            if constexpr (Epi::MIDK) { if (t == (nt >> 1)) E.midk(acc, cur, wr, wc, fr, fq, lds); }
            const bool last = (t == nt - 2);
            const char* a1 = cA + (size_t)(t + 1) * kstep;
            const char* a2 = last ? nA : cA + (size_t)(t + 2) * kstep; const char* b2 = last ? nB : cB + (size_t)(t + 2) * kstep;
            const char* a3 = a2 + kstep; const char* b3 = b2 + kstep;
            if (last && has_next) S.a_ready(nxt);
            if constexpr (SP2) {
            PG8_LDB(B0, 0, 0); PG8_LDB(B1, 0, 1); PG8_SCHED; PG8_LDA(At, 0, 0); PG8_STAGE(PG8_SA(1, 1), a1 + hstep, voffA);
            PG8_WAIT_V(8); PG8_WAIT_L(0); PG8_BAR; PG8_MMA(0, 0, At, B0); PG8_MMA(0, 1, At, B1); PG8_BAR; PG8_SCHED;
            PG8_LDA(At, 0, 1); PG8_STAGE(PG8_SB(0, 0), b2, voffB); PG8_STAGE(PG8_SB(0, 1), b2 + hstep, voffB); PG8_STAGE(PG8_SA(0, 0), a2, voffA);
            PG8_WAIT_V(8); PG8_WAIT_L(0); PG8_BAR; PG8_MMA(1, 0, At, B0); PG8_MMA(1, 1, At, B1); PG8_BAR; PG8_SCHED;
            PG8_LDB(B0, 1, 0); PG8_LDB(B1, 1, 1); PG8_SCHED; PG8_LDA(At, 1, 0); PG8_STAGE(PG8_SA(0, 1), a2 + hstep, voffA);
            PG8_WAIT_V(8); PG8_WAIT_L(0); PG8_BAR; PG8_MMA(0, 0, At, B0); PG8_MMA(0, 1, At, B1); PG8_BAR; PG8_SCHED;
            PG8_LDA(At, 1, 1); PG8_STAGE(PG8_SB(1, 0), b3, voffB); PG8_STAGE(PG8_SB(1, 1), b3 + hstep, voffB); PG8_STAGE(PG8_SA(1, 0), a3, voffA);
            PG8_WAIT_V(8); PG8_WAIT_L(0); PG8_BAR; PG8_MMA(1, 0, At, B0); PG8_MMA(1, 1, At, B1); PG8_BAR; PG8_SCHED;
            } else {
            PG8_LDB(B0, 0, 0); PG8_SCHED; PG8_LDA(At, 0, 0); PG8_STAGE(PG8_SA(1, 1), a1 + hstep, voffA);
            PG8_WAIT_L(8); PG8_BAR; PG8_WAIT_L(0); PG8_MMA(0, 0, At, B0); PG8_BAR; PG8_SCHED;
            PG8_LDB(B1, 0, 1); PG8_STAGE(PG8_SB(0, 0), b2, voffB);
            PG8_BAR; PG8_WAIT_L(0); PG8_MMA(0, 1, At, B1); PG8_BAR;
            PG8_LDA(At, 0, 1); PG8_STAGE(PG8_SA(0, 0), a2, voffA);
            PG8_BAR; PG8_WAIT_L(0); PG8_MMA(1, 0, At, B0); PG8_BAR; PG8_SCHED;
            PG8_STAGE(PG8_SB(0, 1), b2 + hstep, voffB);
            PG8_WAIT_V(6); PG8_BAR; PG8_MMA(1, 1, At, B1); PG8_BAR;
            PG8_LDB(B0, 1, 0); PG8_SCHED; PG8_LDA(At, 1, 0); PG8_STAGE(PG8_SA(0, 1), a2 + hstep, voffA);
            PG8_WAIT_L(8); PG8_BAR; PG8_WAIT_L(0); PG8_MMA(0, 0, At, B0); PG8_BAR; PG8_SCHED;
            PG8_LDB(B1, 1, 1); PG8_STAGE(PG8_SB(1, 0), b3, voffB);
            PG8_BAR; PG8_WAIT_L(0); PG8_MMA(0, 1, At, B1); PG8_BAR;
            PG8_LDA(At, 1, 1); PG8_STAGE(PG8_SA(1, 0), a3, voffA);
            PG8_BAR; PG8_WAIT_L(0); PG8_MMA(1, 0, At, B0); PG8_BAR; PG8_SCHED;
            PG8_STAGE(PG8_SB(1, 1), b3 + hstep, voffB);
            PG8_WAIT_V(6); PG8_BAR; PG8_MMA(1, 1, At, B1); PG8_BAR;
            }
        }
        if constexpr (ALIGN_EPI) { if (wr == 0) PG8_BAR; }
        if constexpr (!Epi::AFTER_DRAIN) { E(acc, cur, wr, wc, fr, fq); S.done(cur); }
        if (!has_next) break;
#pragma unroll
        for (int a = 0; a < 2; ++a)
#pragma unroll
            for (int b = 0; b < 2; ++b)
#pragma unroll
                for (int m = 0; m < 4; ++m)
#pragma unroll
                    for (int n = 0; n < 2; ++n) acc[a][b][m][n] = (f32x4){0.f, 0.f, 0.f, 0.f};
        cur = nxt; cA = nA; cB = nB; ++ui;
        if constexpr (ALIGN_EPI) { if (wr == 1) PG8_BAR; }
    }
    PG8_WAIT_V(0);
    if constexpr (!ALIGN_EPI) { if (wr == 0) PG8_BAR; }
    PG8_BAR;
    if constexpr (Epi::AFTER_DRAIN) { E.fused(acc, cur, wr, wc, fr, fq, lds, wid, lane); S.done(cur); }
#undef PG8_SA
#undef PG8_SB
#undef PG8_STAGE
#undef PG8_LDA
#undef PG8_LDB
#undef PG8_MMA
#undef PG8_WAIT_V
#undef PG8_WAIT_L
#undef PG8_BAR
#undef PG8_SCHED
}
}

constexpr int NWAVES = 8;
constexpr int BATCH = 2, SEQ = 4096, D = 2048, M = BATCH * SEQ;
constexpr int AW = 1024, LW = 1024, HD = 128, NH = 8, NLB = 8, LBS = 128, FF = 5632, INW = 5120, GUW = 2 * FF;
constexpr float RMS_EPS = 1e-6f;
constexpr float C2 = 1.4426950408889634f * 0.08838834764831845f;

#ifndef MK_N_LAUNCHES
#define MK_N_LAUNCHES 1
#endif

constexpr size_t MiB = 1u << 20;
constexpr size_t WS_CTL = 0, CTL_ZERO_BYTES = 1 * MiB;
constexpr size_t WS_WIN = 2 * MiB;
constexpr size_t WS_WOUT = 22 * MiB;
constexpr size_t WS_WGU = 30 * MiB;
constexpr size_t WS_WDN = 74 * MiB;
constexpr size_t WS_WRG = 96 * MiB;
constexpr size_t WS_WIG = WS_WRG + 256 * 1024;
constexpr size_t WS_SSQA = 97 * MiB;
constexpr size_t WS_SSQL = WS_SSQA + 256 * 1024;
constexpr size_t WS_XCH = 98 * MiB;
constexpr size_t WS_XN = 100 * MiB;
constexpr size_t WS_Q = 132 * MiB, WS_K = 148 * MiB, WS_VT = 164 * MiB, WS_XL = 180 * MiB, WS_GL = 196 * MiB;
constexpr size_t WS_Y = 212 * MiB;
constexpr size_t WS_H = 132 * MiB;
constexpr size_t WS_MBUF = 132 * MiB;
constexpr size_t WS_FBUF = 2 * MiB;
constexpr size_t WS_ATMP = WS_XN;
constexpr size_t WS_END = 256 * MiB;
constexpr size_t WS_LAGG = 244 * MiB;

constexpr int CW_TMO = 0, CW_CODE = 1, CW_BAR = 4096;

constexpr int RING_OFF = 0, RING_BYTES = 131072;
constexpr int LDSCTL_OFF = RING_BYTES, MISC_OFF = LDSCTL_OFF + 320;
constexpr int RS_OFF = RING_BYTES + 1024;
constexpr int LDS_BYTES = 147456;

#define GAS __attribute__((address_space(1)))
#define LAS __attribute__((address_space(3)))
typedef unsigned short bf16;
typedef unsigned v4u __attribute__((ext_vector_type(4)));
typedef unsigned v2u __attribute__((ext_vector_type(2)));
typedef float f32x4 __attribute__((ext_vector_type(4)));
typedef float f32x2 __attribute__((ext_vector_type(2)));
typedef GAS unsigned gu32;
typedef GAS unsigned long long gu64;
#define RLX_AGENT __ATOMIC_RELAXED, __HIP_MEMORY_SCOPE_AGENT
#define LDS_WAIT() asm volatile("s_waitcnt lgkmcnt(0)" ::: "memory")
#define VM_WAIT() asm volatile("s_waitcnt vmcnt(0)" ::: "memory")
__device__ __forceinline__ unsigned f2bf(float f) { unsigned u = __builtin_bit_cast(unsigned, f); return (u + 0x7fffu + ((u >> 16) & 1u)) >> 16; }
__device__ __forceinline__ unsigned pk2(float lo, float hi) { return f2bf(lo) | (f2bf(hi) << 16); }
__device__ __forceinline__ float bf2f(unsigned h) { return __builtin_bit_cast(float, h << 16); }
__device__ __forceinline__ float bflo(unsigned w) { return __builtin_bit_cast(float, w << 16); }
__device__ __forceinline__ float bfhi(unsigned w) { return __builtin_bit_cast(float, w & 0xffff0000u); }

#define XB_TMO      128
#define XB_XCNT(j)  (256  + 64 * (j))
#define XB_XSUB(j)  (1280 + 64 * (j))
#define XB_XGEN(j)  (2304 + 64 * (j))
#define XB_TOP      3328
#define XB_TOPGEN   3392
#define XCD_BAR_WORDS 3456
#define XB_SPIN_CAP (1u << 18)
__device__ __forceinline__ unsigned xb_ld(unsigned* p)              { return __hip_atomic_load(p, __ATOMIC_RELAXED, __HIP_MEMORY_SCOPE_AGENT); }
__device__ __forceinline__ unsigned xb_add(unsigned* p, unsigned v) { return __hip_atomic_fetch_add(p, v, __ATOMIC_RELAXED, __HIP_MEMORY_SCOPE_AGENT); }
__device__ __forceinline__ unsigned xb_xcc_id() { return (unsigned)__builtin_amdgcn_s_getreg((3 << 11) | 20) & 0xFu; }
#define XB_SPIN(cond, bar) do { unsigned _sp = 0; while (cond) { __builtin_amdgcn_s_sleep(1); \
    if ((++_sp & 255u) == 0u) { if (xb_ld(&(bar)[XB_TMO])) break; if (_sp > XB_SPIN_CAP) { atomicAdd(&(bar)[XB_TMO], 1u); break; } } } } while (0)
struct XcdBarrier { unsigned* bar; unsigned x; volatile LAS unsigned* st; };
__device__ __forceinline__ XcdBarrier xcd_barrier_post(unsigned* bar, volatile LAS unsigned* st) {
    XcdBarrier b; b.bar = bar; b.x = xb_xcc_id(); b.st = st;
    if (threadIdx.x == 0) (void)xb_add(&bar[XB_XCNT(b.x)], 1u);
    return b;
}
__device__ __forceinline__ void xcd_barrier_complete(unsigned* bar, unsigned x, unsigned& nloc, unsigned& nx) {
    const unsigned G = gridDim.x * gridDim.y * gridDim.z;
    unsigned sum, cnt, mine, sp = 0u;
    for (;;) {
        sum = 0u; cnt = 0u; mine = 0u;
#pragma unroll
        for (unsigned j = 0; j < 16; ++j) { const unsigned c = xb_ld(&bar[XB_XCNT(j)]); sum += c; cnt += (c > 0u) ? 1u : 0u; mine = (j == x) ? c : mine; }
        if (sum == G) break;
        __builtin_amdgcn_s_sleep(1);
        if ((++sp & 255u) == 0u) { if (xb_ld(&bar[XB_TMO])) break; if (sp > XB_SPIN_CAP) { atomicAdd(&bar[XB_TMO], 1u); break; } }
    }
    nloc = mine > 0u ? mine : 1u; nx = cnt > 0u ? cnt : 1u;
}
__device__ __forceinline__ void xcd_barrier(const XcdBarrier& b) {
    asm volatile("s_waitcnt vmcnt(0)" ::: "memory");
    __syncthreads();
    if (threadIdx.x == 0) {
        unsigned* bar = b.bar;
        __builtin_amdgcn_s_waitcnt(0);
        unsigned nloc = b.st[0], nx = b.st[1];
        if (nloc == 0u) { xcd_barrier_complete(bar, b.x, nloc, nx); b.st[0] = nloc; b.st[1] = nx; }
        const unsigned old = xb_add(&bar[XB_XSUB(b.x)], 1u);
        const unsigned gen = old / nloc;
        if (old + 1u == (gen + 1u) * nloc) {
            __builtin_amdgcn_fence(__ATOMIC_RELEASE, "agent");
            asm volatile("s_waitcnt vmcnt(0)" ::: "memory");
            const unsigned og = xb_add(&bar[XB_TOP], 1u);
            const unsigned tg = og / nx;
            if (og + 1u == (tg + 1u) * nx) xb_add(&bar[XB_TOPGEN], 1u);
            else XB_SPIN(xb_ld(&bar[XB_TOPGEN]) == tg, bar);
            __builtin_amdgcn_fence(__ATOMIC_ACQUIRE, "agent");
            xb_add(&bar[XB_XGEN(b.x)], 1u);
            asm volatile("s_waitcnt vmcnt(0)" ::: "memory");
        } else {
            XB_SPIN(xb_ld(&bar[XB_XGEN(b.x)]) == gen, bar);
            __builtin_amdgcn_fence(__ATOMIC_ACQUIRE, "agent");
            asm volatile("s_waitcnt vmcnt(0)" ::: "memory");
        }
    }
    __syncthreads();
}

namespace pg8 {
struct EpiInProj {
    static constexpr bool PERM = true, AFTER_DRAIN = false, MIDK = false;
    bf16_t *Q, *K, *VT, *XL, *GL;
    __device__ __forceinline__ void operator()(const f32x4 (&acc)[2][2][4][2], const Unit& u, int wr, int wc, int fr, int fq) const {
        const int t = u.pn >> 2, colt = (u.pn & 3) * BM;
        const int row0 = u.pm * BM + wr * 64 + fr;
        if (t != 2) {
            bf16_t* base = (t == 0) ? Q : (t == 1) ? K : (t == 3) ? XL : GL;
            const float sc = (t == 0) ? C2 : 1.f;
            const int col0 = colt + wc * 32 + 8 * fq;
#pragma unroll
            for (int ai = 0; ai < 2; ++ai)
#pragma unroll
                for (int m = 0; m < 4; ++m) { bf16_t* rowp = base + (size_t)(row0 + ai * HALF + m * 16) * 1024 + col0;
#pragma unroll
                    for (int bj = 0; bj < 2; ++bj) { const f32x4 v0 = acc[ai][bj][m][0] * sc, v1 = acc[ai][bj][m][1] * sc;
                        u32x4 w; w.x = cvt_pk_bf16(v0[0], v0[1]); w.y = cvt_pk_bf16(v0[2], v0[3]); w.z = cvt_pk_bf16(v1[0], v1[1]); w.w = cvt_pk_bf16(v1[2], v1[3]);
                        *(u32x4*)(rowp + bj * HALF) = w; } }
        } else {
#pragma unroll
            for (int ai = 0; ai < 2; ++ai)
#pragma unroll
                for (int m = 0; m < 4; ++m) { const int row = row0 + ai * HALF + m * 16; const int b = row >> 12, s = row & 4095;
                    const int sp = (s & ~12) | ((s & 4) << 1) | ((s & 8) >> 1);
#pragma unroll
                    for (int bj = 0; bj < 2; ++bj)
#pragma unroll
                        for (int n = 0; n < 2; ++n)
#pragma unroll
                            for (int i = 0; i < 4; ++i) { const int c = colt + bj * HALF + wc * 32 + 8 * fq + 4 * n + i; const int hd = c >> 7, d = c & 127;
                                VT[(size_t)((b * 8 + hd) * 128 + d) * 4096 + sp] = (bf16_t)(cvt_pk_bf16(acc[ai][bj][m][n][i], 0.f) & 0xffffu); } }
        }
    }
};
struct EpiOutProjF32 {
    static constexpr bool PERM = false, AFTER_DRAIN = false, MIDK = true;
    float* O; int ldc; PG8_LAS unsigned char* ldsb;
    __device__ __forceinline__ void midk(f32x4 (&acc)[2][2][4][2], const Unit& u, int wr, int wc, int fr, int fq, PG8_LAS unsigned char* lds) const {
        const PG8_LAS f32x2* RS = (const PG8_LAS f32x2*)(lds + ::RS_OFF);
#pragma unroll
        for (int ai = 0; ai < 2; ++ai)
#pragma unroll
            for (int m = 0; m < 4; ++m) { const float f = RS[ai * HALF + wr * 64 + m * 16 + fr].x;
#pragma unroll
                for (int bj = 0; bj < 2; ++bj)
#pragma unroll
                    for (int n = 0; n < 2; ++n) acc[ai][bj][m][n] *= f; }
    }
    __device__ __forceinline__ void operator()(const f32x4 (&acc)[2][2][4][2], const Unit& u, int wr, int wc, int fr, int fq) const {
        const PG8_LAS f32x2* RS = (const PG8_LAS f32x2*)(ldsb + ::RS_OFF);
        const int col0 = u.pn * BM + wc * 32 + 4 * fq;
#pragma unroll
        for (int ai = 0; ai < 2; ++ai)
#pragma unroll
            for (int m = 0; m < 4; ++m) { const int r = ai * HALF + wr * 64 + m * 16 + fr; const float f = RS[r].y; float* rowp = O + (size_t)(u.pm * BM + r) * ldc + col0;
#pragma unroll
                for (int bj = 0; bj < 2; ++bj)
#pragma unroll
                    for (int n = 0; n < 2; ++n) *(f32x4*)(rowp + bj * HALF + n * 16) = acc[ai][bj][m][n] * f; }
    }
};
struct EpiF32 {
    static constexpr bool PERM = false, AFTER_DRAIN = false, MIDK = false;
    float* O; int ldc;
    __device__ __forceinline__ void operator()(const f32x4 (&acc)[2][2][4][2], const Unit& u, int wr, int wc, int fr, int fq) const {
        const int col0 = u.pn * BM + wc * 32 + 4 * fq;
#pragma unroll
        for (int ai = 0; ai < 2; ++ai)
#pragma unroll
            for (int m = 0; m < 4; ++m) { const int r = ai * HALF + wr * 64 + m * 16 + fr; float* rowp = O + (size_t)(u.pm * BM + r) * ldc + col0;
#pragma unroll
                for (int bj = 0; bj < 2; ++bj)
#pragma unroll
                    for (int n = 0; n < 2; ++n) *(f32x4*)(rowp + bj * HALF + n * 16) = acc[ai][bj][m][n]; }
    }
};
struct EpiSwiGLU {
    static constexpr bool PERM = true, AFTER_DRAIN = false, MIDK = false;
    bf16_t* H;
    __device__ __forceinline__ void operator()(const f32x4 (&acc)[2][2][4][2], const Unit& u, int wr, int wc, int fr, int fq) const {
        const int row0 = u.pm * BM + wr * 64 + fr, col0 = u.pn * HALF + wc * 32 + 8 * fq;
#pragma unroll
        for (int ai = 0; ai < 2; ++ai)
#pragma unroll
            for (int m = 0; m < 4; ++m) { bf16_t* rowp = H + (size_t)(row0 + ai * HALF + m * 16) * FF + col0;
                float h[8];
#pragma unroll
                for (int n = 0; n < 2; ++n)
#pragma unroll
                    for (int i = 0; i < 4; ++i) { const float g = acc[ai][0][m][n][i], up = acc[ai][1][m][n][i];
                        const float e = __builtin_amdgcn_exp2f(-1.4426950408889634f * g); h[4 * n + i] = g * __builtin_amdgcn_rcpf(1.0f + e) * up; }
                u32x4 w; w.x = cvt_pk_bf16(h[0], h[1]); w.y = cvt_pk_bf16(h[2], h[3]); w.z = cvt_pk_bf16(h[4], h[5]); w.w = cvt_pk_bf16(h[6], h[7]);
                *(u32x4*)rowp = w; }
    }
};
}

struct Frame {
    LAS unsigned char* lds;
    volatile LAS unsigned* MISC;
    gu32* ctl;
    int tid, lane, wave, vcu, G;
    const float* x; float* out;
    const float *g_premix, *g_postmix, *g_preffn, *g_postffn, *w_in, *conv_w, *conv_b, *w_rg, *b_rg, *w_ig, *b_ig, *lam, *g_attn, *g_lru, *w_out, *w_gate, *w_up, *w_down;
    bf16 *WIN, *WOUT, *WGU, *WDN, *WRG, *WIG;
    bf16 *XN, *Q, *K, *VT, *XL, *GL, *Y, *H;
    float *SSQA, *SSQL, *XCH, *MBUF, *FBUF, *ATMP;
    unsigned char* ws;
};

__device__ __forceinline__ float wave_sum(float v) {
#pragma unroll
    for (int o = 1; o < 64; o <<= 1) v += __shfl_xor(v, o);
    return v;
}

__device__ __forceinline__ void p0_transpose_item(const float* W, int ldw, bf16* WT, int ldt, int trow0, const float* kscale, LAS float* scr, int k0, int n0, int lane) {
#pragma unroll 8
    for (int i = 0; i < 32; ++i) { const int kk = 2 * i + (lane >> 5); scr[kk * 33 + (lane & 31)] = W[(size_t)(k0 + kk) * ldw + n0 + (lane & 31)]; }
    LDS_WAIT(); asm volatile("" ::: "memory");
    const int c = lane & 7;
    float ks[8];
#pragma unroll
    for (int q = 0; q < 8; ++q) ks[q] = kscale ? kscale[8 * c + q] : 1.f;
#pragma unroll
    for (int j = 0; j < 4; ++j) { const int n = (lane >> 3) + 8 * j; const LAS float* s = scr + (8 * c) * 33 + n;
        v4u o; o.x = pk2(s[0 * 33] * ks[0], s[1 * 33] * ks[1]); o.y = pk2(s[2 * 33] * ks[2], s[3 * 33] * ks[3]); o.z = pk2(s[4 * 33] * ks[4], s[5 * 33] * ks[5]); o.w = pk2(s[6 * 33] * ks[6], s[7 * 33] * ks[7]);
        *(GAS v4u*)(WT + (size_t)(trow0 + n) * ldt + k0 + 8 * c) = o; }
    LDS_WAIT(); asm volatile("" ::: "memory");
}
__device__ __forceinline__ void rms_row_to_bf16(int lane, const float* xrow, const float* g, bf16* orow) {
    const GAS f32x4* xr = (const GAS f32x4*)xrow + lane;
    f32x4 v[8]; float s = 0.f;
#pragma unroll
    for (int j = 0; j < 8; ++j) { v[j] = xr[64 * j]; s += (v[j].x * v[j].x + v[j].y * v[j].y) + (v[j].z * v[j].z + v[j].w * v[j].w); }
    const float rstd = 1.f / sqrtf(wave_sum(s) * (1.f / D) + RMS_EPS);
    GAS v2u* o8 = (GAS v2u*)orow + lane;
#pragma unroll
    for (int j = 0; j < 8; ++j) { const f32x4 gg = ((const GAS f32x4*)g)[64 * j + lane]; v2u w; w.x = pk2(v[j].x * rstd * gg.x, v[j].y * rstd * gg.y); w.y = pk2(v[j].z * rstd * gg.z, v[j].w * rstd * gg.w); o8[64 * j] = w; }
}
__device__ __forceinline__ void p0_prologue(Frame& F) {
    LAS float* scr = (LAS float*)(F.lds + RING_OFF + F.wave * 16384);
    const int gw = F.vcu * NWAVES + F.wave, NGW = F.G * NWAVES;
    constexpr int I_IN = (D / 64) * (INW / 32), I_OUT = (D / 64) * (D / 32), I_G = (D / 64) * (FF / 32), I_DN = (FF / 64) * (D / 32), I_LG = 8 * 2 * 4;
    constexpr int NITEMS = I_IN + I_OUT + 2 * I_G + I_DN + 2 * I_LG;
    for (int it = gw; it < NITEMS; it += NGW) {
        int r = it;
        if (r < I_IN) { const int kb = r / (INW / 32), nb = r % (INW / 32); p0_transpose_item(F.w_in, INW, F.WIN, D, 32 * nb, nullptr, scr, 64 * kb, 32 * nb, F.lane); continue; } r -= I_IN;
        if (r < I_OUT) { const int kb = r / (D / 32), nb = r % (D / 32); const int k0 = 64 * kb; const float* ks = (k0 < AW) ? F.g_attn + k0 : F.g_lru + (k0 - AW);
            p0_transpose_item(F.w_out, D, F.WOUT, D, 32 * nb, ks, scr, k0, 32 * nb, F.lane); continue; } r -= I_OUT;
        if (r < I_G) { const int kb = r / (FF / 32), nb = r % (FF / 32); const int n0 = 32 * nb; p0_transpose_item(F.w_gate, FF, F.WGU, D, (n0 >> 7) * 256 + (n0 & 127), nullptr, scr, 64 * kb, n0, F.lane); continue; } r -= I_G;
        if (r < I_G) { const int kb = r / (FF / 32), nb = r % (FF / 32); const int n0 = 32 * nb; p0_transpose_item(F.w_up, FF, F.WGU, D, (n0 >> 7) * 256 + 128 + (n0 & 127), nullptr, scr, 64 * kb, n0, F.lane); continue; } r -= I_G;
        if (r < I_DN) { const int kb = r / (D / 32), nb = r % (D / 32); p0_transpose_item(F.w_down, D, F.WDN, FF, 32 * nb, nullptr, scr, 64 * kb, 32 * nb, F.lane); continue; } r -= I_DN;
        if (r < I_LG) { const int blk = r >> 3, kb = (r >> 2) & 1, nb = r & 3; p0_transpose_item(F.w_rg + blk * 16384, 128, F.WRG + blk * 16384, 128, 32 * nb, nullptr, scr, 64 * kb, 32 * nb, F.lane); continue; } r -= I_LG;
        { const int blk = r >> 3, kb = (r >> 2) & 1, nb = r & 3; p0_transpose_item(F.w_ig + blk * 16384, 128, F.WIG + blk * 16384, 128, 32 * nb, nullptr, scr, 64 * kb, 32 * nb, F.lane); }
    }
    for (int m = gw; m < M; m += NGW) rms_row_to_bf16(F.lane, F.x + (size_t)m * D, F.g_premix, F.XN + (size_t)m * D);
    { GAS v4u* z = (GAS v4u*)(F.ws + WS_LAGG); const int gt = F.vcu * NWAVES * 64 + F.tid, NGT = F.G * NWAVES * 64;
      for (int i = gt; i < (int)(2 * MiB / 16); i += NGT) z[i] = (v4u){0u, 0u, 0u, 0u}; }
}

__device__ __forceinline__ float softplus2(float z2) {
    return fmaxf(z2, 0.f) + __builtin_amdgcn_logf(1.0f + __builtin_amdgcn_exp2f(-fabsf(z2)));
}
__device__ __forceinline__ void p2_attn_naive(Frame& F) {
    const int gw = F.vcu * NWAVES + F.wave, NGW = F.G * NWAVES, lane = F.lane;
    for (int qi = gw; qi < M * NH; qi += NGW) {
        const int t = qi >> 4, bh = qi & 15, b = bh >> 3, h = bh & 7;
        const size_t row = (size_t)b * SEQ + t;
        const unsigned qw = *(const GAS unsigned*)(F.Q + row * 1024 + h * 128 + 2 * lane);
        const float q0 = bflo(qw), q1 = bfhi(qw);
        float run = 0.f, o0 = 0.f, o1 = 0.f;
        const bf16* Kp = F.K + (size_t)b * SEQ * 1024 + h * 128 + 2 * lane;
        const bf16* Vp = F.VT + (size_t)(bh * 128 + 2 * lane) * 4096;
        for (int s = t - 1; s >= 0; --s) {
            const unsigned kw = *(const GAS unsigned*)(Kp + (size_t)s * 1024);
            const float z2 = wave_sum(q0 * bflo(kw) + q1 * bfhi(kw));
            const float L = -softplus2(z2);
            const float w = __builtin_amdgcn_exp2f(z2 + L + run);
            run += L;
            const int sp = (s & ~12) | ((s & 4) << 1) | ((s & 8) >> 1);
            o0 += w * bf2f(Vp[sp]); o1 += w * bf2f(Vp[4096 + sp]);
        }
        *(GAS unsigned*)(F.Y + row * 2048 + h * 128 + 2 * lane) = pk2(o0, o1);
        const float ss = wave_sum(o0 * o0 + o1 * o1);
        if (lane == 0) F.SSQA[row * 8 + h] = ss;
    }
}
__device__ __forceinline__ float gelu_tanh(float g) {
    const float u = 0.7978845608028654f * (g + 0.044715f * g * g * g);
    const float e = __builtin_amdgcn_exp2f(-2.0f * 1.4426950408889634f * fabsf(u));
    const float th = (1.0f - e) / (1.0f + e);
    return 0.5f * g * (1.0f + (u < 0.f ? -th : th));
}
__device__ __forceinline__ void p2_lru_gates_naive(Frame& F) {
    LAS float* xc = (LAS float*)(F.lds + RING_OFF);
    float* BT = F.out;
    for (int row = F.vcu; row < M; row += F.G) {
        const int t = row & (SEQ - 1);
#pragma unroll
        for (int j = 0; j < 2; ++j) { const int ch = F.tid + 512 * j; float a = F.conv_b[ch];
#pragma unroll
            for (int k = 0; k < 4; ++k) { const int tt = t - 3 + k; if (tt >= 0) a += F.conv_w[k * LW + ch] * bf2f(F.XL[(size_t)(row - 3 + k) * 1024 + ch]); }
            xc[ch] = a; }
        __syncthreads();
#pragma unroll
        for (int j = 0; j < 2; ++j) { const int ch = F.tid + 512 * j, blk = ch >> 7, d = ch & 127;
            float rr = F.b_rg[ch], ii = F.b_ig[ch];
            const float* wr_ = F.w_rg + blk * 16384 + d; const float* wi_ = F.w_ig + blk * 16384 + d; const LAS float* xb = xc + blk * 128;
            for (int c = 0; c < 128; ++c) { const float xv = xb[c]; rr += xv * wr_[c * 128]; ii += xv * wi_[c * 128]; }
            const float r = 1.0f / (1.0f + expf(-rr)), i = 1.0f / (1.0f + expf(-ii));
            const float lam = F.lam[ch]; const float lsl = -(fmaxf(-lam, 0.f) + log1pf(expf(-fabsf(lam))));
            const float log_a = 8.0f * r * lsl; const float a = expf(log_a); const float mult = sqrtf(-expm1f(2.0f * log_a));
            F.ATMP[(size_t)row * 1024 + ch] = a; BT[(size_t)row * 1024 + ch] = mult * (i * xc[ch]); }
        __syncthreads();
    }
}
__device__ __forceinline__ void p2_lru_scan_naive(Frame& F) {
    const int gt = blockIdx.x * (NWAVES * 64) + F.tid;
    const float* BT = F.out;
    if (gt < BATCH * LW) { const int b = gt >> 10, ch = gt & 1023; float h = 0.f;
        for (int t = 0; t < SEQ; ++t) { const size_t row = (size_t)b * SEQ + t;
            h = F.ATMP[row * 1024 + ch] * h + BT[row * 1024 + ch];
            const float y = h * gelu_tanh(bf2f(F.GL[row * 1024 + ch]));
            F.Y[row * 2048 + 1024 + ch] = (bf16)f2bf(y); } }
}
__device__ __forceinline__ void p2_lru_ssq_naive(Frame& F) {
    const int gw = F.vcu * NWAVES + F.wave, NGW = F.G * NWAVES, lane = F.lane;
    for (int row = gw; row < M; row += NGW) { const GAS v4u* p = (const GAS v4u*)(F.Y + (size_t)row * 2048 + 1024 + 16 * lane);
        const v4u a = p[0], b = p[1]; float s = 0.f;
#pragma unroll
        for (int q = 0; q < 4; ++q) { const float x0 = bflo(a[q]), x1 = bfhi(a[q]), x2 = bflo(b[q]), x3 = bfhi(b[q]); s += (x0 * x0 + x1 * x1) + (x2 * x2 + x3 * x3); }
        s += __shfl_xor(s, 1); s += __shfl_xor(s, 2); s += __shfl_xor(s, 4);
        if ((lane & 7) == 0) F.SSQL[(size_t)row * 8 + (lane >> 3)] = s; }
}
__device__ __forceinline__ void p3b_rows(Frame& F) {
    const int gw = F.vcu * NWAVES + F.wave, NGW = F.G * NWAVES, lane = F.lane;
    for (int row = gw; row < M; row += NGW) {
        const GAS f32x4* mr = (const GAS f32x4*)(F.MBUF + (size_t)row * D) + lane; const GAS f32x4* xr = (const GAS f32x4*)(F.x + (size_t)row * D) + lane;
        f32x4 v[8]; float s = 0.f;
#pragma unroll
        for (int j = 0; j < 8; ++j) { v[j] = mr[64 * j]; s += (v[j].x * v[j].x + v[j].y * v[j].y) + (v[j].z * v[j].z + v[j].w * v[j].w); }
        const float rstd = 1.f / sqrtf(wave_sum(s) * (1.f / D) + RMS_EPS); float s2 = 0.f;
        GAS f32x4* orow = (GAS f32x4*)(F.out + (size_t)row * D) + lane;
#pragma unroll
        for (int j = 0; j < 8; ++j) { const f32x4 gg = ((const GAS f32x4*)F.g_postmix)[64 * j + lane]; v[j] = xr[64 * j] + v[j] * rstd * gg; orow[64 * j] = v[j];
            s2 += (v[j].x * v[j].x + v[j].y * v[j].y) + (v[j].z * v[j].z + v[j].w * v[j].w); }
        const float rstd2 = 1.f / sqrtf(wave_sum(s2) * (1.f / D) + RMS_EPS);
        GAS v2u* o8 = (GAS v2u*)(F.XN + (size_t)row * D) + lane;
#pragma unroll
        for (int j = 0; j < 8; ++j) { const f32x4 gg = ((const GAS f32x4*)F.g_preffn)[64 * j + lane]; v2u w; w.x = pk2(v[j].x * rstd2 * gg.x, v[j].y * rstd2 * gg.y); w.y = pk2(v[j].z * rstd2 * gg.z, v[j].w * rstd2 * gg.w); o8[64 * j] = w; }
    }
}
__device__ __forceinline__ void p5b_rows(Frame& F) {
    const int gw = F.vcu * NWAVES + F.wave, NGW = F.G * NWAVES, lane = F.lane;
    for (int row = gw; row < M; row += NGW) {
        const GAS f32x4* fr_ = (const GAS f32x4*)(F.FBUF + (size_t)row * D) + lane;
        f32x4 v[8]; float s = 0.f;
#pragma unroll
        for (int j = 0; j < 8; ++j) { v[j] = fr_[64 * j]; s += (v[j].x * v[j].x + v[j].y * v[j].y) + (v[j].z * v[j].z + v[j].w * v[j].w); }
        const float rstd = 1.f / sqrtf(wave_sum(s) * (1.f / D) + RMS_EPS);
        GAS f32x4* orow = (GAS f32x4*)(F.out + (size_t)row * D) + lane;
#pragma unroll
        for (int j = 0; j < 8; ++j) { const f32x4 gg = ((const GAS f32x4*)F.g_postffn)[64 * j + lane]; orow[64 * j] = orow[64 * j] + v[j] * rstd * gg; }
    }
}
__device__ __forceinline__ void p3_row_table(Frame& F, int pm) {
    LAS f32x2* RS = (LAS f32x2*)(F.lds + RS_OFF);
    if (F.tid < 256) { const size_t row = (size_t)pm * 256 + F.tid; const GAS f32x4* a = (const GAS f32x4*)(F.SSQA + row * 8); const GAS f32x4* l = (const GAS f32x4*)(F.SSQL + row * 8);
        const f32x4 a0 = a[0], a1 = a[1], l0 = l[0], l1 = l[1];
        const float sa = ((a0.x + a0.y) + (a0.z + a0.w)) + ((a1.x + a1.y) + (a1.z + a1.w)), sl = ((l0.x + l0.y) + (l0.z + l0.w)) + ((l1.x + l1.y) + (l1.z + l1.w));
        const float ra = 1.f / sqrtf(sa * (1.f / AW) + RMS_EPS), rl = 1.f / sqrtf(sl * (1.f / LW) + RMS_EPS);
        RS[F.tid] = (f32x2){ra / rl, rl}; }
    __syncthreads();
}

constexpr int PH_P0 = 0, PH_P1 = 1, PH_P2A = 2, PH_P2B = 3, PH_P2C = 4, PH_P3 = 5, PH_P3B = 6, PH_P4 = 7, PH_P5 = 8, PH_P5B = 9, N_PHASES = 10;
struct Args { const float* in[19]; float* out; unsigned char* ws; int ph_lo, ph_hi, li, pad; };
__global__ void __launch_bounds__(NWAVES * 64, 2) hymba_fwd(Args args) {
    extern __shared__ __attribute__((aligned(16))) unsigned char lds[];
    Frame F;
    F.lds = (LAS unsigned char*)lds;
    F.MISC = (volatile LAS unsigned*)(F.lds + MISC_OFF);
    F.tid = threadIdx.x; F.lane = F.tid & 63; F.wave = __builtin_amdgcn_readfirstlane(F.tid >> 6);
    F.G = gridDim.x; { const int bx = blockIdx.x; F.vcu = (F.G % 8 == 0) ? (bx % 8) * (F.G / 8) + bx / 8 : bx; }
    unsigned char* ws = args.ws; F.ws = ws;
    F.ctl = (gu32*)(ws + WS_CTL);
    F.x = args.in[0]; F.g_premix = args.in[1]; F.g_postmix = args.in[2]; F.g_preffn = args.in[3]; F.g_postffn = args.in[4]; F.w_in = args.in[5]; F.conv_w = args.in[6]; F.conv_b = args.in[7];
    F.w_rg = args.in[8]; F.b_rg = args.in[9]; F.w_ig = args.in[10]; F.b_ig = args.in[11]; F.lam = args.in[12]; F.g_attn = args.in[13]; F.g_lru = args.in[14]; F.w_out = args.in[15];
    F.w_gate = args.in[16]; F.w_up = args.in[17]; F.w_down = args.in[18]; F.out = args.out;
    F.WIN = (bf16*)(ws + WS_WIN); F.WOUT = (bf16*)(ws + WS_WOUT); F.WGU = (bf16*)(ws + WS_WGU); F.WDN = (bf16*)(ws + WS_WDN); F.WRG = (bf16*)(ws + WS_WRG); F.WIG = (bf16*)(ws + WS_WIG);
    F.XN = (bf16*)(ws + WS_XN); F.Q = (bf16*)(ws + WS_Q); F.K = (bf16*)(ws + WS_K); F.VT = (bf16*)(ws + WS_VT); F.XL = (bf16*)(ws + WS_XL); F.GL = (bf16*)(ws + WS_GL); F.Y = (bf16*)(ws + WS_Y); F.H = (bf16*)(ws + WS_H);
    F.SSQA = (float*)(ws + WS_SSQA); F.SSQL = (float*)(ws + WS_SSQL); F.XCH = (float*)(ws + WS_XCH); F.MBUF = (float*)(ws + WS_MBUF); F.FBUF = (float*)(ws + WS_FBUF); F.ATMP = (float*)(ws + WS_ATMP);
    for (int u = F.tid; u < (LDS_BYTES - LDSCTL_OFF) / 4; u += NWAVES * 64) ((LAS unsigned*)(F.lds + LDSCTL_OFF))[u] = 0u;
    __syncthreads();
    const bool one_launch = (MK_N_LAUNCHES == 1);
    XcdBarrier bar; bar.bar = (unsigned*)(F.ctl + CW_BAR); bar.x = 0; bar.st = nullptr;
    if (one_launch) bar = xcd_barrier_post((unsigned*)(F.ctl + CW_BAR), F.MISC + 8);
    const int lo = args.ph_lo, hi = args.ph_hi;
#define IN(k) (lo <= (k) && (k) < hi)
#define SEAM(k) do { if (IN(k) && IN((k) + 1)) xcd_barrier(bar); } while (0)

    if (IN(PH_P0)) { p0_prologue(F); } SEAM(PH_P0);
    if (IN(PH_P1)) {
        pg8::Gemm g{F.XN, F.WIN, M, INW, D}; pg8::StaticOrder S; S.init(M, INW, F.G, (int)blockIdx.x);
        pg8::EpiInProj E{F.Q, F.K, F.VT, F.XL, F.GL};
        pg8::gemm_phase<pg8::EpiInProj, pg8::StaticOrder, true, true>(F.lds + RING_OFF, g, S, E);
    } SEAM(PH_P1);
    if (IN(PH_P2A)) { p2_lru_gates_naive(F); p2_attn_naive(F); } SEAM(PH_P2A);
    if (IN(PH_P2B)) { p2_lru_scan_naive(F); } SEAM(PH_P2B);
    if (IN(PH_P2C)) { p2_lru_ssq_naive(F); } SEAM(PH_P2C);
    if (IN(PH_P3)) {
        pg8::Gemm g{F.Y, F.WOUT, M, D, D}; pg8::StaticOrder S; S.init(M, D, F.G, (int)blockIdx.x);
        pg8::Unit u0; if (S.next(0, u0)) p3_row_table(F, u0.pm); else __syncthreads();
        pg8::EpiOutProjF32 E{F.MBUF, D, F.lds};
        pg8::gemm_phase<pg8::EpiOutProjF32, pg8::StaticOrder, false, true>(F.lds + RING_OFF, g, S, E);
    } SEAM(PH_P3);
    if (IN(PH_P3B)) { p3b_rows(F); } SEAM(PH_P3B);
    if (IN(PH_P4)) {
        pg8::Gemm g{F.XN, F.WGU, M, GUW, D}; pg8::StaticOrder S; S.init(M, GUW, F.G, (int)blockIdx.x);
        pg8::EpiSwiGLU E{F.H};
        pg8::gemm_phase<pg8::EpiSwiGLU, pg8::StaticOrder, true, true>(F.lds + RING_OFF, g, S, E);
    } SEAM(PH_P4);
    if (IN(PH_P5)) {
        pg8::Gemm g{F.H, F.WDN, M, D, FF}; pg8::StaticOrder S; S.init(M, D, F.G, (int)blockIdx.x);
        pg8::EpiF32 E{F.FBUF, D};
        pg8::gemm_phase<pg8::EpiF32, pg8::StaticOrder, false, true>(F.lds + RING_OFF, g, S, E);
    } SEAM(PH_P5);
    if (IN(PH_P5B)) { p5b_rows(F); }
#undef IN
#undef SEAM
}

extern "C" void kernel_launch(void* const* d_in, const int* in_sizes, int n_in, void* d_out, int out_size, void* d_ws, size_t ws_size, hipStream_t stream) {
    static int grid = 0;
    if (grid == 0) {
        if (n_in != 19 || in_sizes[0] != M * D || out_size != M * D || ws_size < WS_END) { fprintf(stderr, "kernel_launch: unexpected shapes (n_in %d, in0 %d, out %d, ws %zu); nothing launched\n", n_in, n_in > 0 ? in_sizes[0] : -1, out_size, ws_size); grid = -1; return; }
        int dev = 0, cus = 0, per_cu = 0;
        if (hipGetDevice(&dev) != hipSuccess || hipDeviceGetAttribute(&cus, hipDeviceAttributeMultiprocessorCount, dev) != hipSuccess) { grid = -1; return; }
        if (hipFuncSetAttribute((const void*)hymba_fwd, hipFuncAttributeMaxDynamicSharedMemorySize, LDS_BYTES) != hipSuccess) { fprintf(stderr, "kernel_launch: hipFuncSetAttribute failed\n"); grid = -1; return; }
        if (hipOccupancyMaxActiveBlocksPerMultiprocessor(&per_cu, (const void*)hymba_fwd, NWAVES * 64, LDS_BYTES) != hipSuccess || per_cu < 1)
            fprintf(stderr, "kernel_launch: note: occupancy query reports %d workgroups per CU\n", per_cu);
        (void)hipGetLastError();
        grid = cus;
    }
    if (grid < 0) return;
    if (hipMemsetAsync((char*)d_ws + WS_CTL, 0, CTL_ZERO_BYTES, stream) != hipSuccess) { fprintf(stderr, "kernel_launch: hipMemsetAsync failed\n"); return; }
    Args a{};
    for (int i = 0; i < 19; ++i) a.in[i] = (const float*)d_in[i];
    a.out = (float*)d_out; a.ws = (unsigned char*)d_ws;
#if MK_N_LAUNCHES == 1
    a.ph_lo = 0; a.ph_hi = N_PHASES; a.li = 0;
    hipLaunchKernelGGL(hymba_fwd, dim3(grid), dim3(NWAVES * 64), LDS_BYTES, stream, a);
#else
    for (int li = 0; li < N_PHASES; ++li) { a.ph_lo = li; a.ph_hi = li + 1; a.li = li;
        hipLaunchKernelGGL(hymba_fwd, dim3(grid), dim3(NWAVES * 64), LDS_BYTES, stream, a); }
#endif
    const hipError_t le = hipPeekAtLastError();
    if (le != hipSuccess) fprintf(stderr, "kernel_launch: launch failed: %s\n", hipGetErrorName(le));
}
```

```cpp
#include <hip/hip_runtime.h>
#include <cstdio>
#include <cstdint>
#define MK_N_LAUNCHES 1
#define FAST_ATTN 1
#define FAST_LRU 1
namespace pg8 {
#define PG8_LAS __attribute__((address_space(3)))
typedef unsigned short bf16_t;
typedef short bf16x8 __attribute__((ext_vector_type(8)));
typedef float f32x4 __attribute__((ext_vector_type(4)));
typedef unsigned u32x4 __attribute__((ext_vector_type(4)));
constexpr int BM = 256, BK = 64, HALF = 128, HTB = HALF * BK * 2  , STAGE_BYTES = 8 * HTB, NXCD = 8, WGM = 8;

__host__ __device__ __forceinline__ int lds_byte(int r, int c) { const int st = (r >> 4) * 2 + (c >> 5), rr = r & 15, cc = c & 31, ob = rr * 64 + cc * 2; return st * 1024 + (ob ^ (((ob >> 9) & 1) << 5)); }
__host__ __device__ __forceinline__ void stage_rc(int b, int& R, int& C) { const int st = b / 1024, sb = b % 1024, swz = sb ^ (((sb >> 9) & 1) << 5); R = (st >> 1) * 16 + swz / 64; C = (st & 1) * 32 + (swz % 64) / 2; }
__host__ __device__ __forceinline__ int perm32(int rho) { const int n = rho >> 4, i = rho & 15; return 8 * (i >> 2) + 4 * n + (i & 3); }

struct Unit { int pm, pn; };
struct Gemm { const bf16_t* A; const bf16_t* Bt; int M, N, K; };

struct StaticOrder {
    int nM, nN, nwg, G, c;
    __host__ __device__ void init(int M, int N, int G_, int c_) { nM = M / BM; nN = N / BM; nwg = nM * nN; G = G_; c = c_; }
    __host__ __device__ bool next(int i, Unit& u) const {
        const long L = (long)i * G + c; if (L >= nwg) return false;
        int wgid = (int)L; { const int q = nwg / NXCD, r = nwg % NXCD, xcd = wgid % NXCD, off = wgid / NXCD; wgid = (xcd < r ? xcd * (q + 1) : r * (q + 1) + (xcd - r) * q) + off; }
        const int nig = WGM * nN, gid = wgid / nig, fm = gid * WGM, gsz = (nM - fm) < WGM ? (nM - fm) : WGM;
        u.pm = fm + ((wgid % nig) % gsz); u.pn = (wgid % nig) / gsz; return true;
    }
    __device__ __forceinline__ void a_ready(const Unit&) const {}
    __device__ __forceinline__ void done(const Unit&) const {}
};

__device__ __forceinline__ unsigned cvt_pk_bf16(float lo, float hi) { unsigned r; asm volatile("v_cvt_pk_bf16_f32 %0, %1, %2" : "=v"(r) : "v"(lo), "v"(hi)); return r; }
typedef float f32x2 __attribute__((ext_vector_type(2)));
__device__ __forceinline__ f32x2 gelu_pk(f32x2 v) {
    const f32x2 av = __builtin_elementwise_abs(v), d = av * 0.2316418882f + 1.0f;
    f32x2 t; t.x = __builtin_amdgcn_rcpf(d.x); t.y = __builtin_amdgcn_rcpf(d.y);
    f32x2 q = t * 0.5307027145f + (-0.7265760135f); q = q * t + 0.7107068705f; q = q * t + (-0.142248368f); q = q * t + 0.127414796f; q = q * t;
    const f32x2 s = (v * v) * (-0.72134752044f);
    f32x2 e; e.x = __builtin_amdgcn_exp2f(s.x); e.y = __builtin_amdgcn_exp2f(s.y);
    const f32x2 m = v * (q * e), r = v - m;
    f32x2 o; o.x = v.x < 0.f ? m.x : r.x; o.y = v.y < 0.f ? m.y : r.y; return o;
}

template <int ACT  > struct EpiBf16 {
    static constexpr bool PERM = true, AFTER_DRAIN = false; static_assert(ACT == 0 || ACT == 1, "EpiBf16: ACT is 0 (none) or 1 (gelu_pk)");
    bf16_t* O; int ldc; const float* bias; int split_cols; size_t split_stride; float scale0;
    __device__ __forceinline__ void operator()(const f32x4 (&acc)[2][2][4][2], const Unit& u, int wr, int wc, int fr, int fq) const {
        const int row0 = u.pm * BM + wr * 64 + fr; int colt = u.pn * BM; bf16_t* base = O;
        float sc = 1.f; if (split_cols) { const int t = colt / split_cols; base += (size_t)t * split_stride; colt -= t * split_cols; if (t == 0) sc = scale0; }
        const int col0 = colt + wc * 32 + 8 * fq, bcol0 = u.pn * BM + wc * 32 + 8 * fq;
        f32x4 bv[2][2];
#pragma unroll
        for (int bj = 0; bj < 2; ++bj)
#pragma unroll
            for (int n = 0; n < 2; ++n) bv[bj][n] = bias ? *(const f32x4*)(bias + bcol0 + bj * HALF + 4 * n) : (f32x4){0.f, 0.f, 0.f, 0.f};
#pragma unroll
        for (int ai = 0; ai < 2; ++ai)
#pragma unroll
            for (int m = 0; m < 4; ++m) { bf16_t* rowp = base + (size_t)(row0 + ai * HALF + m * 16) * ldc + col0;
#pragma unroll
                for (int bj = 0; bj < 2; ++bj) { f32x4 v0 = acc[ai][bj][m][0] + bv[bj][0], v1 = acc[ai][bj][m][1] + bv[bj][1];
                    if (ACT == 1) { f32x2 a = gelu_pk((f32x2){v0[0], v0[1]}), b = gelu_pk((f32x2){v0[2], v0[3]}), c = gelu_pk((f32x2){v1[0], v1[1]}), d = gelu_pk((f32x2){v1[2], v1[3]});
                        v0 = (f32x4){a.x, a.y, b.x, b.y}; v1 = (f32x4){c.x, c.y, d.x, d.y}; }
                    v0 = v0 * sc; v1 = v1 * sc; u32x4 w; w.x = cvt_pk_bf16(v0[0], v0[1]); w.y = cvt_pk_bf16(v0[2], v0[3]); w.z = cvt_pk_bf16(v1[0], v1[1]); w.w = cvt_pk_bf16(v1[2], v1[3]);
                    *(u32x4*)(rowp + bj * HALF) = w; } }
    }
};

struct PanelStats {
    unsigned* xbuf;
    unsigned* cnt;
    unsigned* tmo;
    int ntn; float eps;
    unsigned code;
    __device__ __forceinline__ bool run(const f32x4 (&v)[2][2][4][2], const Unit& u, int wr, int wc, int fr, int fq, PG8_LAS unsigned char* lds, int wid, int lane) const {
        typedef float f32x2v __attribute__((ext_vector_type(2)));
        PG8_LAS f32x2v* P = (PG8_LAS f32x2v*)lds;
        PG8_LAS f32x2v* S = (PG8_LAS f32x2v*)(lds + 8192);
        PG8_LAS unsigned* flag = (PG8_LAS unsigned*)(lds + 8192 + 2048);
#pragma unroll
        for (int ai = 0; ai < 2; ++ai)
#pragma unroll
            for (int m = 0; m < 4; ++m) {
                float s = 0.f;
#pragma unroll
                for (int bj = 0; bj < 2; ++bj)
#pragma unroll
                    for (int n = 0; n < 2; ++n) { const f32x4 x = v[ai][bj][m][n]; s += (x[0] + x[1]) + (x[2] + x[3]); }
                s += __shfl_xor(s, 16); s += __shfl_xor(s, 32);
                const float mw = s * (1.0f / 64.0f); float q = 0.f;
#pragma unroll
                for (int bj = 0; bj < 2; ++bj)
#pragma unroll
                    for (int n = 0; n < 2; ++n) { const f32x4 d = v[ai][bj][m][n] - mw; q += (d[0] * d[0] + d[1] * d[1]) + (d[2] * d[2] + d[3] * d[3]); }
                q += __shfl_xor(q, 16); q += __shfl_xor(q, 32);
                if (fq == 0) P[(ai * HALF + wr * 64 + m * 16 + fr) * 4 + wc] = (f32x2v){mw, q};
            }
        asm volatile("s_waitcnt lgkmcnt(0)" ::: "memory"); __builtin_amdgcn_s_barrier(); asm volatile("" ::: "memory");
#if defined(BROKEN_EXCHANGE_NO_WAIT)
#warning BROKEN CONTROL BUILD: the row-statistics exchange does not wait; results are wrong by design
        if (blockIdx.x >= 64) { const long long t0_ = clock64(); while (clock64() - t0_ < 60000) __builtin_amdgcn_s_sleep(8); }
#endif
        const int row = wid * 32 + (lane & 31);
        if (lane < 32) {
            const f32x2v a = P[row * 4 + 0], b = P[row * 4 + 1], c = P[row * 4 + 2], d = P[row * 4 + 3];
            const float mt = (a.x + b.x + c.x + d.x) * 0.25f;
            const float da = a.x - mt, db = b.x - mt, dc = c.x - mt, dd = d.x - mt;
            const float m2 = (a.y + b.y) + (c.y + d.y) + 64.0f * ((da * da + db * db) + (dc * dc + dd * dd));
            unsigned long long* slot = (unsigned long long*)xbuf + ((size_t)(u.pm * BM + row) * 4 + u.pn);
            __hip_atomic_store(slot, ((unsigned long long)__float_as_uint(m2) << 32) | __float_as_uint(mt), __ATOMIC_RELAXED, __HIP_MEMORY_SCOPE_AGENT);
        }
        asm volatile("s_waitcnt vmcnt(0)" ::: "memory");
        if (lane == 0) __hip_atomic_fetch_add(cnt + 64 * u.pm, 1u, __ATOMIC_RELAXED, __HIP_MEMORY_SCOPE_AGENT);
        if (wid == 0) {
            bool dead = false; const unsigned long long t0 = __builtin_amdgcn_s_memrealtime(); const unsigned want = 8u * (unsigned)ntn;
            for (;;) {
#if defined(BROKEN_EXCHANGE_NO_WAIT)
                break;
#endif
                if ((unsigned)__builtin_amdgcn_readfirstlane(__hip_atomic_load(cnt + 64 * u.pm, __ATOMIC_RELAXED, __HIP_MEMORY_SCOPE_AGENT)) >= want) break;
                if (__builtin_amdgcn_s_memrealtime() - t0 > 2000000ull) {
                    if (lane == 0) { unsigned expect = 0u; __hip_atomic_compare_exchange_strong(tmo + 1, &expect, code | (unsigned)(u.pm & 0xff), __ATOMIC_RELAXED, __ATOMIC_RELAXED, __HIP_MEMORY_SCOPE_AGENT);
                                     __hip_atomic_store(tmo, 1u, __ATOMIC_RELAXED, __HIP_MEMORY_SCOPE_AGENT); }
                    dead = true; break; }
                __builtin_amdgcn_s_sleep(2);
            }
            __builtin_amdgcn_fence(__ATOMIC_ACQUIRE, "agent");
            if (lane == 0) flag[0] = dead ? 1u : 0u;
        }
        asm volatile("s_waitcnt vmcnt(0) lgkmcnt(0)" ::: "memory"); __builtin_amdgcn_s_barrier(); asm volatile("" ::: "memory");
        const bool bad = flag[0] != 0u;
        if (lane < 32) {
            const unsigned long long* slot = (const unsigned long long*)xbuf + (size_t)(u.pm * BM + row) * 4; float mt[4], m2[4]; float ms = 0.f;
#pragma unroll
            for (int t = 0; t < 4; ++t) { if (t < ntn) { const unsigned long long w = __hip_atomic_load(slot + t, __ATOMIC_RELAXED, __HIP_MEMORY_SCOPE_AGENT); mt[t] = __uint_as_float((unsigned)w); m2[t] = __uint_as_float((unsigned)(w >> 32)); } else { mt[t] = 0.f; m2[t] = 0.f; } ms += mt[t]; }
            const float mean = ms / (float)ntn; float q = 0.f;
#pragma unroll
            for (int t = 0; t < 4; ++t) if (t < ntn) { const float dm = mt[t] - mean; q += m2[t] + 256.0f * dm * dm; }
            S[row] = (f32x2v){mean, 1.0f / sqrtf(q / (256.0f * (float)ntn) + eps)};
        }
        asm volatile("s_waitcnt lgkmcnt(0)" ::: "memory"); __builtin_amdgcn_s_barrier(); asm volatile("" ::: "memory");
        return bad;
    }
};
struct EpiLnRes {
    static constexpr bool PERM = false, AFTER_DRAIN = true;
    const float* base; float* out; int ldc; const float* bias; PanelStats st; unsigned poison;
    __device__ __forceinline__ void fused(f32x4 (&acc)[2][2][4][2], const Unit& u, int wr, int wc, int fr, int fq, PG8_LAS unsigned char* lds, int wid, int lane) const {
        typedef float f32x2v __attribute__((ext_vector_type(2)));
        const PG8_LAS f32x2v* S = (const PG8_LAS f32x2v*)(lds + 8192);
        const int col0 = u.pn * BM + wc * 32 + 4 * fq;
#pragma unroll
        for (int bj = 0; bj < 2; ++bj)
#pragma unroll
            for (int n = 0; n < 2; ++n) { const f32x4 bv = bias ? *(const f32x4*)(bias + col0 + bj * HALF + n * 16) : (f32x4){0.f, 0.f, 0.f, 0.f};
#pragma unroll
                for (int ai = 0; ai < 2; ++ai)
#pragma unroll
                    for (int m = 0; m < 4; ++m) acc[ai][bj][m][n] += bv; }
        f32x4 pre[4][2][2];
#pragma unroll
        for (int m = 0; m < 4; ++m) { const size_t off = (size_t)(u.pm * BM + wr * 64 + m * 16 + fr) * ldc + col0;
#pragma unroll
            for (int bj = 0; bj < 2; ++bj)
#pragma unroll
                for (int n = 0; n < 2; ++n) pre[m][bj][n] = *(const f32x4*)(base + off + bj * HALF + n * 16); }
        const bool bad = st.run(acc, u, wr, wc, fr, fq, lds, wid, lane) || poison != 0u;
        const float qnan = __builtin_nanf("");
#pragma unroll
        for (int ai = 0; ai < 2; ++ai)
#pragma unroll
            for (int m = 0; m < 4; ++m) { const int r = ai * HALF + wr * 64 + m * 16 + fr; const f32x2v sr = S[r]; const size_t off = (size_t)(u.pm * BM + r) * ldc + col0;
#pragma unroll
                for (int bj = 0; bj < 2; ++bj)
#pragma unroll
                    for (int n = 0; n < 2; ++n) { const f32x4 bs = ai == 0 ? pre[m][bj][n] : *(const f32x4*)(base + off + bj * HALF + n * 16); f32x4 o = bs + (acc[ai][bj][m][n] - sr.x) * sr.y;
                        if (bad) o = (f32x4){qnan, qnan, qnan, qnan}; *(f32x4*)(out + off + bj * HALF + n * 16) = o; }
                if (m & 1) asm volatile("" ::: "memory"); }
    }
};
struct EpiLnResLn {
    static constexpr bool PERM = false, AFTER_DRAIN = true;
    const float* base; float* out; bf16_t* xn; int ldc; const float* bias; PanelStats st1, st2; unsigned poison;
    __device__ __forceinline__ void fused(f32x4 (&acc)[2][2][4][2], const Unit& u, int wr, int wc, int fr, int fq, PG8_LAS unsigned char* lds, int wid, int lane) const {
        typedef float f32x2v __attribute__((ext_vector_type(2))); typedef unsigned u32x2v __attribute__((ext_vector_type(2)));
        const PG8_LAS f32x2v* S = (const PG8_LAS f32x2v*)(lds + 8192);
        const int col0 = u.pn * BM + wc * 32 + 4 * fq;
#pragma unroll
        for (int bj = 0; bj < 2; ++bj)
#pragma unroll
            for (int n = 0; n < 2; ++n) { const f32x4 bv = bias ? *(const f32x4*)(bias + col0 + bj * HALF + n * 16) : (f32x4){0.f, 0.f, 0.f, 0.f};
#pragma unroll
                for (int ai = 0; ai < 2; ++ai)
#pragma unroll
                    for (int m = 0; m < 4; ++m) acc[ai][bj][m][n] += bv; }
        bool bad = st1.run(acc, u, wr, wc, fr, fq, lds, wid, lane) || poison != 0u;
        const float qnan = __builtin_nanf("");
#pragma unroll
        for (int ai = 0; ai < 2; ++ai)
#pragma unroll
            for (int m = 0; m < 4; ++m) { const int r = ai * HALF + wr * 64 + m * 16 + fr; const f32x2v sr = S[r]; const size_t off = (size_t)(u.pm * BM + r) * ldc + col0;
#pragma unroll
                for (int bj = 0; bj < 2; ++bj)
#pragma unroll
                    for (int n = 0; n < 2; ++n) { const f32x4 bs = *(const f32x4*)(base + off + bj * HALF + n * 16); acc[ai][bj][m][n] = bs + (acc[ai][bj][m][n] - sr.x) * sr.y; }
                asm volatile("" : "+v"(acc[ai][0][m][0]), "+v"(acc[ai][0][m][1]), "+v"(acc[ai][1][m][0]), "+v"(acc[ai][1][m][1]));
                if (m & 1) asm volatile("" ::: "memory"); }
        const bool bad1 = bad;
        bad = st2.run(acc, u, wr, wc, fr, fq, lds, wid, lane) || bad;
#pragma unroll
        for (int ai = 0; ai < 2; ++ai)
#pragma unroll
            for (int m = 0; m < 4; ++m) { const int r = ai * HALF + wr * 64 + m * 16 + fr; const f32x2v sr = S[r]; const size_t off = (size_t)(u.pm * BM + r) * ldc + col0;
#pragma unroll
                for (int bj = 0; bj < 2; ++bj)
#pragma unroll
                    for (int n = 0; n < 2; ++n) { const f32x4 x1 = acc[ai][bj][m][n]; *(f32x4*)(out + off + bj * HALF + n * 16) = bad1 ? (f32x4){qnan, qnan, qnan, qnan} : x1;
                        const f32x4 o = (x1 - sr.x) * sr.y; u32x2v w; w.x = cvt_pk_bf16(o[0], o[1]); w.y = cvt_pk_bf16(o[2], o[3]);
                        if (bad) { w.x = 0x7fc07fc0u; w.y = 0x7fc07fc0u; } *(u32x2v*)(xn + off + bj * HALF + n * 16) = w; }
                asm volatile("" ::: "memory"); }
    }
};

template <class Epi, class Sched, bool ALIGN_EPI = false, bool SP2 = false>
__device__ __forceinline__ void gemm_phase(PG8_LAS unsigned char* lds, const Gemm g, const Sched& S, const Epi& E) {
    const int tid = threadIdx.x, wid = __builtin_amdgcn_readfirstlane(tid >> 6), lane = tid & 63, wr = wid >> 2, wc = wid & 3, fr = lane & 15, fq = lane >> 4;
    const int K = g.K, nt = K / BK;
    unsigned voffA[2], voffB[2];
#pragma unroll
    for (int i = 0; i < 2; ++i) { int R, C; stage_rc(tid * 16 + i * 8192, R, C); const int Rb = Epi::PERM ? ((R & ~31) + perm32(R & 31)) : R;
        voffA[i] = (unsigned)(R * K + C) * 2u; voffB[i] = (unsigned)(Rb * K + C) * 2u; }
    const size_t kstep = (size_t)(BK * 2);
    const size_t hstep = (size_t)HALF * K * 2;
    const size_t tstep = 2 * hstep;
    const unsigned ldsw = (unsigned)wid * 1024u;
    const int aoff = lds_byte(wr * 64 + fr, fq * 8), boff = lds_byte(wc * 32 + fr, fq * 8);
#define PG8_SA(b, h) (((b) * 2 + (h)) * HTB)
#define PG8_SB(b, h) ((4 + (b) * 2 + (h)) * HTB)
#define PG8_STAGE(bufoff, gbase, voff) do { _Pragma("unroll") for (int _i = 0; _i < 2; ++_i) \
        __builtin_amdgcn_global_load_lds((const unsigned*)((const char*)(gbase) + (voff)[_i]), (PG8_LAS unsigned*)(lds + (bufoff) + ldsw + _i * 8192), 16, 0, 0); } while (0)
#define PG8_LDA(dst, b, h) do { _Pragma("unroll") for (int m = 0; m < 4; ++m) _Pragma("unroll") for (int k = 0; k < 2; ++k) dst[m][k] = *(const PG8_LAS bf16x8*)(lds + PG8_SA(b, h) + aoff + m * 2048 + k * 1024); } while (0)
#define PG8_LDB(dst, b, h) do { _Pragma("unroll") for (int n = 0; n < 2; ++n) _Pragma("unroll") for (int k = 0; k < 2; ++k) dst[n][k] = *(const PG8_LAS bf16x8*)(lds + PG8_SB(b, h) + boff + n * 2048 + k * 1024); } while (0)
#define PG8_MMA(ai, bj, At, Bt) do { __builtin_amdgcn_s_setprio(1); _Pragma("unroll") for (int m = 0; m < 4; ++m) _Pragma("unroll") for (int n = 0; n < 2; ++n) _Pragma("unroll") for (int k = 0; k < 2; ++k) \
        acc[ai][bj][m][n] = __builtin_amdgcn_mfma_f32_16x16x32_bf16(Bt[n][k], At[m][k], acc[ai][bj][m][n], 0, 0, 0); __builtin_amdgcn_s_setprio(0); } while (0)
#define PG8_WAIT_V(n) asm volatile("s_waitcnt vmcnt(" #n ")" ::: "memory")
#define PG8_WAIT_L(n) asm volatile("s_waitcnt lgkmcnt(" #n ")" ::: "memory")
#define PG8_BAR __builtin_amdgcn_s_barrier()
#define PG8_SCHED __builtin_amdgcn_sched_barrier(0)
    Unit cur, nxt; int ui = 0;
    if (!S.next(0, cur)) return;
    f32x4 acc[2][2][4][2];
#pragma unroll
    for (int a = 0; a < 2; ++a)
#pragma unroll
        for (int b = 0; b < 2; ++b)
#pragma unroll
            for (int m = 0; m < 4; ++m)
#pragma unroll
                for (int n = 0; n < 2; ++n) acc[a][b][m][n] = (f32x4){0.f, 0.f, 0.f, 0.f};
    bf16x8 At[4][2], B0[2][2], B1[2][2];
    const char* cA = (const char*)g.A + (size_t)cur.pm * tstep; const char* cB = (const char*)g.Bt + (size_t)cur.pn * tstep;
    S.a_ready(cur);
    if constexpr (SP2) {
        PG8_STAGE(PG8_SB(0, 0), cB, voffB); PG8_STAGE(PG8_SB(0, 1), cB + hstep, voffB); PG8_STAGE(PG8_SA(0, 0), cA, voffA); PG8_STAGE(PG8_SA(0, 1), cA + hstep, voffA);
        if (wr == 1) PG8_BAR;
        PG8_WAIT_V(2); PG8_BAR;
        PG8_STAGE(PG8_SB(1, 0), cB + kstep, voffB); PG8_STAGE(PG8_SA(1, 0), cA + kstep, voffA); PG8_STAGE(PG8_SB(1, 1), cB + hstep + kstep, voffB);
        PG8_WAIT_V(6); PG8_BAR;
    } else {
        PG8_STAGE(PG8_SB(0, 0), cB, voffB); PG8_STAGE(PG8_SA(0, 0), cA, voffA); PG8_STAGE(PG8_SB(0, 1), cB + hstep, voffB); PG8_STAGE(PG8_SA(0, 1), cA + hstep, voffA);
        if (wr == 1) PG8_BAR;
        PG8_WAIT_V(4); PG8_BAR;
        PG8_STAGE(PG8_SB(1, 0), cB + kstep, voffB); PG8_STAGE(PG8_SA(1, 0), cA + kstep, voffA); PG8_STAGE(PG8_SB(1, 1), cB + hstep + kstep, voffB);
        PG8_WAIT_V(6); PG8_BAR;
    }
    for (;;) {
        const bool has_next = S.next(ui + 1, nxt);
        const char* nA = has_next ? (const char*)g.A + (size_t)nxt.pm * tstep : cA; const char* nB = has_next ? (const char*)g.Bt + (size_t)nxt.pn * tstep : cB;
        for (int t = 0; t < nt; t += 2) {
            if constexpr (Epi::MIDK) { if (t == (nt >> 1)) E.midk(acc, cur, wr, wc, fr, fq, lds); }
            const bool last = (t == nt - 2);
            const char* a1 = cA + (size_t)(t + 1) * kstep;
            const char* a2 = last ? nA : cA + (size_t)(t + 2) * kstep; const char* b2 = last ? nB : cB + (size_t)(t + 2) * kstep;
            const char* a3 = a2 + kstep; const char* b3 = b2 + kstep;
            if (last && has_next) S.a_ready(nxt);
            if constexpr (SP2) {
            PG8_LDB(B0, 0, 0); PG8_LDB(B1, 0, 1); PG8_SCHED; PG8_LDA(At, 0, 0); PG8_STAGE(PG8_SA(1, 1), a1 + hstep, voffA);
            PG8_WAIT_V(8); PG8_WAIT_L(0); PG8_BAR; PG8_MMA(0, 0, At, B0); PG8_MMA(0, 1, At, B1); PG8_BAR; PG8_SCHED;
            PG8_LDA(At, 0, 1); PG8_STAGE(PG8_SB(0, 0), b2, voffB); PG8_STAGE(PG8_SB(0, 1), b2 + hstep, voffB); PG8_STAGE(PG8_SA(0, 0), a2, voffA);
            PG8_WAIT_V(8); PG8_WAIT_L(0); PG8_BAR; PG8_MMA(1, 0, At, B0); PG8_MMA(1, 1, At, B1); PG8_BAR; PG8_SCHED;
            PG8_LDB(B0, 1, 0); PG8_LDB(B1, 1, 1); PG8_SCHED; PG8_LDA(At, 1, 0); PG8_STAGE(PG8_SA(0, 1), a2 + hstep, voffA);
            PG8_WAIT_V(8); PG8_WAIT_L(0); PG8_BAR; PG8_MMA(0, 0, At, B0); PG8_MMA(0, 1, At, B1); PG8_BAR; PG8_SCHED;
            PG8_LDA(At, 1, 1); PG8_STAGE(PG8_SB(1, 0), b3, voffB); PG8_STAGE(PG8_SB(1, 1), b3 + hstep, voffB); PG8_STAGE(PG8_SA(1, 0), a3, voffA);
            PG8_WAIT_V(8); PG8_WAIT_L(0); PG8_BAR; PG8_MMA(1, 0, At, B0); PG8_MMA(1, 1, At, B1); PG8_BAR; PG8_SCHED;
            } else {
            PG8_LDB(B0, 0, 0); PG8_SCHED; PG8_LDA(At, 0, 0); PG8_STAGE(PG8_SA(1, 1), a1 + hstep, voffA);
            PG8_WAIT_L(8); PG8_BAR; PG8_WAIT_L(0); PG8_MMA(0, 0, At, B0); PG8_BAR; PG8_SCHED;
            PG8_LDB(B1, 0, 1); PG8_STAGE(PG8_SB(0, 0), b2, voffB);
            PG8_BAR; PG8_WAIT_L(0); PG8_MMA(0, 1, At, B1); PG8_BAR;
            PG8_LDA(At, 0, 1); PG8_STAGE(PG8_SA(0, 0), a2, voffA);
            PG8_BAR; PG8_WAIT_L(0); PG8_MMA(1, 0, At, B0); PG8_BAR; PG8_SCHED;
            PG8_STAGE(PG8_SB(0, 1), b2 + hstep, voffB);
            PG8_WAIT_V(6); PG8_BAR; PG8_MMA(1, 1, At, B1); PG8_BAR;
            PG8_LDB(B0, 1, 0); PG8_SCHED; PG8_LDA(At, 1, 0); PG8_STAGE(PG8_SA(0, 1), a2 + hstep, voffA);
            PG8_WAIT_L(8); PG8_BAR; PG8_WAIT_L(0); PG8_MMA(0, 0, At, B0); PG8_BAR; PG8_SCHED;
            PG8_LDB(B1, 1, 1); PG8_STAGE(PG8_SB(1, 0), b3, voffB);
            PG8_BAR; PG8_WAIT_L(0); PG8_MMA(0, 1, At, B1); PG8_BAR;
            PG8_LDA(At, 1, 1); PG8_STAGE(PG8_SA(1, 0), a3, voffA);
            PG8_BAR; PG8_WAIT_L(0); PG8_MMA(1, 0, At, B0); PG8_BAR; PG8_SCHED;
            PG8_STAGE(PG8_SB(1, 1), b3 + hstep, voffB);
            PG8_WAIT_V(6); PG8_BAR; PG8_MMA(1, 1, At, B1); PG8_BAR;
            }
        }
        if constexpr (ALIGN_EPI) { if (wr == 0) PG8_BAR; }
        if constexpr (!Epi::AFTER_DRAIN) { E(acc, cur, wr, wc, fr, fq); S.done(cur); }
        if (!has_next) break;
#pragma unroll
        for (int a = 0; a < 2; ++a)
#pragma unroll
            for (int b = 0; b < 2; ++b)
#pragma unroll
                for (int m = 0; m < 4; ++m)
#pragma unroll
                    for (int n = 0; n < 2; ++n) acc[a][b][m][n] = (f32x4){0.f, 0.f, 0.f, 0.f};
        cur = nxt; cA = nA; cB = nB; ++ui;
        if constexpr (ALIGN_EPI) { if (wr == 1) PG8_BAR; }
    }
    PG8_WAIT_V(0);
    if constexpr (!ALIGN_EPI) { if (wr == 0) PG8_BAR; }
    PG8_BAR;
    if constexpr (Epi::AFTER_DRAIN) { E.fused(acc, cur, wr, wc, fr, fq, lds, wid, lane); S.done(cur); }
#undef PG8_SA
#undef PG8_SB
#undef PG8_STAGE
#undef PG8_LDA
#undef PG8_LDB
#undef PG8_MMA
#undef PG8_WAIT_V
#undef PG8_WAIT_L
#undef PG8_BAR
#undef PG8_SCHED
}
}

constexpr int NWAVES = 8;
constexpr int BATCH = 2, SEQ = 4096, D = 2048, M = BATCH * SEQ;
constexpr int AW = 1024, LW = 1024, HD = 128, NH = 8, NLB = 8, LBS = 128, FF = 5632, INW = 5120, GUW = 2 * FF;
constexpr float RMS_EPS = 1e-6f;
constexpr float C2 = 1.4426950408889634f * 0.08838834764831845f;

#ifndef FAST_ATTN
#define FAST_ATTN 1
#endif
#ifndef FAST_LRU
#define FAST_LRU 1
#endif
#ifndef MK_N_LAUNCHES
#define MK_N_LAUNCHES 1
#endif

constexpr size_t MiB = 1u << 20;
constexpr size_t WS_CTL = 0, CTL_ZERO_BYTES = 1 * MiB;
constexpr size_t WS_WIN = 2 * MiB;
constexpr size_t WS_WOUT = 22 * MiB;
constexpr size_t WS_WGU = 30 * MiB;
constexpr size_t WS_WDN = 74 * MiB;
constexpr size_t WS_WRG = 96 * MiB;
constexpr size_t WS_WIG = WS_WRG + 256 * 1024;
constexpr size_t WS_SSQA = 97 * MiB;
constexpr size_t WS_SSQL = WS_SSQA + 256 * 1024;
constexpr size_t WS_XCH = 98 * MiB;
constexpr size_t WS_XN = 100 * MiB;
constexpr size_t WS_Q = 132 * MiB, WS_K = 148 * MiB, WS_VT = 164 * MiB, WS_XL = 180 * MiB, WS_GL = 196 * MiB;
constexpr size_t WS_Y = 212 * MiB;
constexpr size_t WS_H = 132 * MiB;
constexpr size_t WS_MBUF = 132 * MiB;
constexpr size_t WS_FBUF = 2 * MiB;
constexpr size_t WS_ATMP = WS_XN;
constexpr size_t WS_END = 256 * MiB;
constexpr size_t WS_LAGG = 244 * MiB;

constexpr int CW_TMO = 0, CW_CODE = 1, CW_BAR = 4096;

constexpr int RING_OFF = 0, RING_BYTES = 131072;
constexpr int LDSCTL_OFF = RING_BYTES, MISC_OFF = LDSCTL_OFF + 320;
constexpr int RS_OFF = RING_BYTES + 1024;
constexpr int LDS_BYTES = 147456;

#define GAS __attribute__((address_space(1)))
#define LAS __attribute__((address_space(3)))
typedef unsigned short bf16;
typedef unsigned v4u __attribute__((ext_vector_type(4)));
typedef unsigned v2u __attribute__((ext_vector_type(2)));
typedef float f32x4 __attribute__((ext_vector_type(4)));
typedef float f32x2 __attribute__((ext_vector_type(2)));
typedef GAS unsigned gu32;
typedef GAS unsigned long long gu64;
#define RLX_AGENT __ATOMIC_RELAXED, __HIP_MEMORY_SCOPE_AGENT
#define LDS_WAIT() asm volatile("s_waitcnt lgkmcnt(0)" ::: "memory")
#define VM_WAIT() asm volatile("s_waitcnt vmcnt(0)" ::: "memory")
__device__ __forceinline__ unsigned f2bf(float f) { unsigned u = __builtin_bit_cast(unsigned, f); return (u + 0x7fffu + ((u >> 16) & 1u)) >> 16; }
__device__ __forceinline__ unsigned pk2(float lo, float hi) { return f2bf(lo) | (f2bf(hi) << 16); }
__device__ __forceinline__ float bf2f(unsigned h) { return __builtin_bit_cast(float, h << 16); }
__device__ __forceinline__ float bflo(unsigned w) { return __builtin_bit_cast(float, w << 16); }
__device__ __forceinline__ float bfhi(unsigned w) { return __builtin_bit_cast(float, w & 0xffff0000u); }

#define XB_TMO      128
#define XB_XCNT(j)  (256  + 64 * (j))
#define XB_XSUB(j)  (1280 + 64 * (j))
#define XB_XGEN(j)  (2304 + 64 * (j))
#define XB_TOP      3328
#define XB_TOPGEN   3392
#define XCD_BAR_WORDS 3456
#define XB_SPIN_CAP (1u << 18)
__device__ __forceinline__ unsigned xb_ld(unsigned* p)              { return __hip_atomic_load(p, __ATOMIC_RELAXED, __HIP_MEMORY_SCOPE_AGENT); }
__device__ __forceinline__ unsigned xb_add(unsigned* p, unsigned v) { return __hip_atomic_fetch_add(p, v, __ATOMIC_RELAXED, __HIP_MEMORY_SCOPE_AGENT); }
__device__ __forceinline__ unsigned xb_xcc_id() { return (unsigned)__builtin_amdgcn_s_getreg((3 << 11) | 20) & 0xFu; }
#define XB_SPIN(cond, bar) do { unsigned _sp = 0; while (cond) { __builtin_amdgcn_s_sleep(1); \
    if ((++_sp & 255u) == 0u) { if (xb_ld(&(bar)[XB_TMO])) break; if (_sp > XB_SPIN_CAP) { atomicAdd(&(bar)[XB_TMO], 1u); break; } } } } while (0)
struct XcdBarrier { unsigned* bar; unsigned x; volatile LAS unsigned* st; };
__device__ __forceinline__ XcdBarrier xcd_barrier_post(unsigned* bar, volatile LAS unsigned* st) {
    XcdBarrier b; b.bar = bar; b.x = xb_xcc_id(); b.st = st;
    if (threadIdx.x == 0) (void)xb_add(&bar[XB_XCNT(b.x)], 1u);
    return b;
}
__device__ __forceinline__ void xcd_barrier_complete(unsigned* bar, unsigned x, unsigned& nloc, unsigned& nx) {
    const unsigned G = gridDim.x * gridDim.y * gridDim.z;
    unsigned sum, cnt, mine, sp = 0u;
    for (;;) {
        sum = 0u; cnt = 0u; mine = 0u;
#pragma unroll
        for (unsigned j = 0; j < 16; ++j) { const unsigned c = xb_ld(&bar[XB_XCNT(j)]); sum += c; cnt += (c > 0u) ? 1u : 0u; mine = (j == x) ? c : mine; }
        if (sum == G) break;
        __builtin_amdgcn_s_sleep(1);
        if ((++sp & 255u) == 0u) { if (xb_ld(&bar[XB_TMO])) break; if (sp > XB_SPIN_CAP) { atomicAdd(&bar[XB_TMO], 1u); break; } }
    }
    nloc = mine > 0u ? mine : 1u; nx = cnt > 0u ? cnt : 1u;
}
__device__ __forceinline__ void xcd_barrier(const XcdBarrier& b) {
    asm volatile("s_waitcnt vmcnt(0)" ::: "memory");
    __syncthreads();
    if (threadIdx.x == 0) {
        unsigned* bar = b.bar;
        __builtin_amdgcn_s_waitcnt(0);
        unsigned nloc = b.st[0], nx = b.st[1];
        if (nloc == 0u) { xcd_barrier_complete(bar, b.x, nloc, nx); b.st[0] = nloc; b.st[1] = nx; }
        const unsigned old = xb_add(&bar[XB_XSUB(b.x)], 1u);
        const unsigned gen = old / nloc;
        if (old + 1u == (gen + 1u) * nloc) {
            __builtin_amdgcn_fence(__ATOMIC_RELEASE, "agent");
            asm volatile("s_waitcnt vmcnt(0)" ::: "memory");
            const unsigned og = xb_add(&bar[XB_TOP], 1u);
            const unsigned tg = og / nx;
            if (og + 1u == (tg + 1u) * nx) xb_add(&bar[XB_TOPGEN], 1u);
            else XB_SPIN(xb_ld(&bar[XB_TOPGEN]) == tg, bar);
            __builtin_amdgcn_fence(__ATOMIC_ACQUIRE, "agent");
            xb_add(&bar[XB_XGEN(b.x)], 1u);
            asm volatile("s_waitcnt vmcnt(0)" ::: "memory");
        } else {
            XB_SPIN(xb_ld(&bar[XB_XGEN(b.x)]) == gen, bar);
            __builtin_amdgcn_fence(__ATOMIC_ACQUIRE, "agent");
            asm volatile("s_waitcnt vmcnt(0)" ::: "memory");
        }
    }
    __syncthreads();
}

namespace pg8 {
struct EpiInProj {
    static constexpr bool PERM = true, AFTER_DRAIN = false, MIDK = false;
    bf16_t *Q, *K, *VT, *XL, *GL;
    __device__ __forceinline__ void operator()(const f32x4 (&acc)[2][2][4][2], const Unit& u, int wr, int wc, int fr, int fq) const {
        const int t = u.pn >> 2, colt = (u.pn & 3) * BM;
        const int row0 = u.pm * BM + wr * 64 + fr;
        if (t != 2) {
            bf16_t* base = (t == 0) ? Q : (t == 1) ? K : (t == 3) ? XL : GL;
            const float sc = (t == 0) ? C2 : 1.f;
            const int col0 = colt + wc * 32 + 8 * fq;
#pragma unroll
            for (int ai = 0; ai < 2; ++ai)
#pragma unroll
                for (int m = 0; m < 4; ++m) { bf16_t* rowp = base + (size_t)(row0 + ai * HALF + m * 16) * 1024 + col0;
#pragma unroll
                    for (int bj = 0; bj < 2; ++bj) { const f32x4 v0 = acc[ai][bj][m][0] * sc, v1 = acc[ai][bj][m][1] * sc;
                        u32x4 w; w.x = cvt_pk_bf16(v0[0], v0[1]); w.y = cvt_pk_bf16(v0[2], v0[3]); w.z = cvt_pk_bf16(v1[0], v1[1]); w.w = cvt_pk_bf16(v1[2], v1[3]);
                        *(u32x4*)(rowp + bj * HALF) = w; } }
        } else {
#pragma unroll
            for (int ai = 0; ai < 2; ++ai)
#pragma unroll
                for (int m = 0; m < 4; ++m) { const int row = row0 + ai * HALF + m * 16; const int b = row >> 12, s = row & 4095;
                    const int sp = (s & ~12) | ((s & 4) << 1) | ((s & 8) >> 1);
#pragma unroll
                    for (int bj = 0; bj < 2; ++bj)
#pragma unroll
                        for (int n = 0; n < 2; ++n)
#pragma unroll
                            for (int i = 0; i < 4; ++i) { const int c = colt + bj * HALF + wc * 32 + 8 * fq + 4 * n + i; const int hd = c >> 7, d = c & 127;
                                VT[(size_t)((b * 8 + hd) * 128 + d) * 4096 + sp] = (bf16_t)(cvt_pk_bf16(acc[ai][bj][m][n][i], 0.f) & 0xffffu); } }
        }
    }
};
struct EpiOutProjF32 {
    static constexpr bool PERM = false, AFTER_DRAIN = false, MIDK = true;
    float* O; int ldc; PG8_LAS unsigned char* ldsb;
    __device__ __forceinline__ void midk(f32x4 (&acc)[2][2][4][2], const Unit& u, int wr, int wc, int fr, int fq, PG8_LAS unsigned char* lds) const {
        const PG8_LAS f32x2* RS = (const PG8_LAS f32x2*)(lds + ::RS_OFF);
#pragma unroll
        for (int ai = 0; ai < 2; ++ai)
#pragma unroll
            for (int m = 0; m < 4; ++m) { const float f = RS[ai * HALF + wr * 64 + m * 16 + fr].x;
#pragma unroll
                for (int bj = 0; bj < 2; ++bj)
#pragma unroll
                    for (int n = 0; n < 2; ++n) acc[ai][bj][m][n] *= f; }
    }
    __device__ __forceinline__ void operator()(const f32x4 (&acc)[2][2][4][2], const Unit& u, int wr, int wc, int fr, int fq) const {
        const PG8_LAS f32x2* RS = (const PG8_LAS f32x2*)(ldsb + ::RS_OFF);
        const int col0 = u.pn * BM + wc * 32 + 4 * fq;
#pragma unroll
        for (int ai = 0; ai < 2; ++ai)
#pragma unroll
            for (int m = 0; m < 4; ++m) { const int r = ai * HALF + wr * 64 + m * 16 + fr; const float f = RS[r].y; float* rowp = O + (size_t)(u.pm * BM + r) * ldc + col0;
#pragma unroll
                for (int bj = 0; bj < 2; ++bj)
#pragma unroll
                    for (int n = 0; n < 2; ++n) *(f32x4*)(rowp + bj * HALF + n * 16) = acc[ai][bj][m][n] * f; }
    }
};
struct EpiF32 {
    static constexpr bool PERM = false, AFTER_DRAIN = false, MIDK = false;
    float* O; int ldc;
    __device__ __forceinline__ void operator()(const f32x4 (&acc)[2][2][4][2], const Unit& u, int wr, int wc, int fr, int fq) const {
        const int col0 = u.pn * BM + wc * 32 + 4 * fq;
#pragma unroll
        for (int ai = 0; ai < 2; ++ai)
#pragma unroll
            for (int m = 0; m < 4; ++m) { const int r = ai * HALF + wr * 64 + m * 16 + fr; float* rowp = O + (size_t)(u.pm * BM + r) * ldc + col0;
#pragma unroll
                for (int bj = 0; bj < 2; ++bj)
#pragma unroll
                    for (int n = 0; n < 2; ++n) *(f32x4*)(rowp + bj * HALF + n * 16) = acc[ai][bj][m][n]; }
    }
};
struct EpiSwiGLU {
    static constexpr bool PERM = true, AFTER_DRAIN = false, MIDK = false;
    bf16_t* H;
    __device__ __forceinline__ void operator()(const f32x4 (&acc)[2][2][4][2], const Unit& u, int wr, int wc, int fr, int fq) const {
        const int row0 = u.pm * BM + wr * 64 + fr, col0 = u.pn * HALF + wc * 32 + 8 * fq;
#pragma unroll
        for (int ai = 0; ai < 2; ++ai)
#pragma unroll
            for (int m = 0; m < 4; ++m) { bf16_t* rowp = H + (size_t)(row0 + ai * HALF + m * 16) * FF + col0;
                float h[8];
#pragma unroll
                for (int n = 0; n < 2; ++n)
#pragma unroll
                    for (int i = 0; i < 4; ++i) { const float g = acc[ai][0][m][n][i], up = acc[ai][1][m][n][i];
                        const float e = __builtin_amdgcn_exp2f(-1.4426950408889634f * g); h[4 * n + i] = g * __builtin_amdgcn_rcpf(1.0f + e) * up; }
                u32x4 w; w.x = cvt_pk_bf16(h[0], h[1]); w.y = cvt_pk_bf16(h[2], h[3]); w.z = cvt_pk_bf16(h[4], h[5]); w.w = cvt_pk_bf16(h[6], h[7]);
                *(u32x4*)rowp = w; }
    }
};
}

struct Frame {
    LAS unsigned char* lds;
    volatile LAS unsigned* MISC;
    gu32* ctl;
    int tid, lane, wave, vcu, G;
    const float* x; float* out;
    const float *g_premix, *g_postmix, *g_preffn, *g_postffn, *w_in, *conv_w, *conv_b, *w_rg, *b_rg, *w_ig, *b_ig, *lam, *g_attn, *g_lru, *w_out, *w_gate, *w_up, *w_down;
    bf16 *WIN, *WOUT, *WGU, *WDN, *WRG, *WIG;
    bf16 *XN, *Q, *K, *VT, *XL, *GL, *Y, *H;
    float *SSQA, *SSQL, *XCH, *MBUF, *FBUF, *ATMP;
    unsigned char* ws;
};

__device__ __forceinline__ float wave_sum(float v) {
#pragma unroll
    for (int o = 1; o < 64; o <<= 1) v += __shfl_xor(v, o);
    return v;
}

__device__ __forceinline__ void p0_transpose_item(const float* W, int ldw, bf16* WT, int ldt, int trow0, const float* kscale, LAS float* scr, int k0, int n0, int lane) {
#pragma unroll 8
    for (int i = 0; i < 32; ++i) { const int kk = 2 * i + (lane >> 5); scr[kk * 33 + (lane & 31)] = W[(size_t)(k0 + kk) * ldw + n0 + (lane & 31)]; }
    LDS_WAIT(); asm volatile("" ::: "memory");
    const int c = lane & 7;
    float ks[8];
#pragma unroll
    for (int q = 0; q < 8; ++q) ks[q] = kscale ? kscale[8 * c + q] : 1.f;
#pragma unroll
    for (int j = 0; j < 4; ++j) { const int n = (lane >> 3) + 8 * j; const LAS float* s = scr + (8 * c) * 33 + n;
        v4u o; o.x = pk2(s[0 * 33] * ks[0], s[1 * 33] * ks[1]); o.y = pk2(s[2 * 33] * ks[2], s[3 * 33] * ks[3]); o.z = pk2(s[4 * 33] * ks[4], s[5 * 33] * ks[5]); o.w = pk2(s[6 * 33] * ks[6], s[7 * 33] * ks[7]);
        *(GAS v4u*)(WT + (size_t)(trow0 + n) * ldt + k0 + 8 * c) = o; }
    LDS_WAIT(); asm volatile("" ::: "memory");
}
__device__ __forceinline__ void rms_row_to_bf16(int lane, const float* xrow, const float* g, bf16* orow) {
    const GAS f32x4* xr = (const GAS f32x4*)xrow + lane;
    f32x4 v[8]; float s = 0.f;
#pragma unroll
    for (int j = 0; j < 8; ++j) { v[j] = xr[64 * j]; s += (v[j].x * v[j].x + v[j].y * v[j].y) + (v[j].z * v[j].z + v[j].w * v[j].w); }
    const float rstd = 1.f / sqrtf(wave_sum(s) * (1.f / D) + RMS_EPS);
    GAS v2u* o8 = (GAS v2u*)orow + lane;
#pragma unroll
    for (int j = 0; j < 8; ++j) { const f32x4 gg = ((const GAS f32x4*)g)[64 * j + lane]; v2u w; w.x = pk2(v[j].x * rstd * gg.x, v[j].y * rstd * gg.y); w.y = pk2(v[j].z * rstd * gg.z, v[j].w * rstd * gg.w); o8[64 * j] = w; }
}
__device__ __forceinline__ void p0_prologue(Frame& F) {
    LAS float* scr = (LAS float*)(F.lds + RING_OFF + F.wave * 16384);
    const int gw = F.vcu * NWAVES + F.wave, NGW = F.G * NWAVES;
    constexpr int I_IN = (D / 64) * (INW / 32), I_OUT = (D / 64) * (D / 32), I_G = (D / 64) * (FF / 32), I_DN = (FF / 64) * (D / 32), I_LG = 8 * 2 * 4;
    constexpr int NITEMS = I_IN + I_OUT + 2 * I_G + I_DN + 2 * I_LG;
    for (int it = gw; it < NITEMS; it += NGW) {
        int r = it;
        if (r < I_IN) { const int kb = r / (INW / 32), nb = r % (INW / 32); p0_transpose_item(F.w_in, INW, F.WIN, D, 32 * nb, nullptr, scr, 64 * kb, 32 * nb, F.lane); continue; } r -= I_IN;
        if (r < I_OUT) { const int kb = r / (D / 32), nb = r % (D / 32); const int k0 = 64 * kb; const float* ks = (k0 < AW) ? F.g_attn + k0 : F.g_lru + (k0 - AW);
            p0_transpose_item(F.w_out, D, F.WOUT, D, 32 * nb, ks, scr, k0, 32 * nb, F.lane); continue; } r -= I_OUT;
        if (r < I_G) { const int kb = r / (FF / 32), nb = r % (FF / 32); const int n0 = 32 * nb; p0_transpose_item(F.w_gate, FF, F.WGU, D, (n0 >> 7) * 256 + (n0 & 127), nullptr, scr, 64 * kb, n0, F.lane); continue; } r -= I_G;
        if (r < I_G) { const int kb = r / (FF / 32), nb = r % (FF / 32); const int n0 = 32 * nb; p0_transpose_item(F.w_up, FF, F.WGU, D, (n0 >> 7) * 256 + 128 + (n0 & 127), nullptr, scr, 64 * kb, n0, F.lane); continue; } r -= I_G;
        if (r < I_DN) { const int kb = r / (D / 32), nb = r % (D / 32); p0_transpose_item(F.w_down, D, F.WDN, FF, 32 * nb, nullptr, scr, 64 * kb, 32 * nb, F.lane); continue; } r -= I_DN;
        if (r < I_LG) { const int blk = r >> 3, kb = (r >> 2) & 1, nb = r & 3; p0_transpose_item(F.w_rg + blk * 16384, 128, F.WRG + blk * 16384, 128, 32 * nb, nullptr, scr, 64 * kb, 32 * nb, F.lane); continue; } r -= I_LG;
        { const int blk = r >> 3, kb = (r >> 2) & 1, nb = r & 3; p0_transpose_item(F.w_ig + blk * 16384, 128, F.WIG + blk * 16384, 128, 32 * nb, nullptr, scr, 64 * kb, 32 * nb, F.lane); }
    }
    for (int m = gw; m < M; m += NGW) rms_row_to_bf16(F.lane, F.x + (size_t)m * D, F.g_premix, F.XN + (size_t)m * D);
    { GAS v4u* z = (GAS v4u*)(F.ws + WS_LAGG); const int gt = F.vcu * NWAVES * 64 + F.tid, NGT = F.G * NWAVES * 64;
      for (int i = gt; i < (int)(2 * MiB / 16); i += NGT) z[i] = (v4u){0u, 0u, 0u, 0u}; }
}

__device__ __forceinline__ float softplus2(float z2) {
    return fmaxf(z2, 0.f) + __builtin_amdgcn_logf(1.0f + __builtin_amdgcn_exp2f(-fabsf(z2)));
}
__device__ __forceinline__ void p2_attn_naive(Frame& F) {
    const int gw = F.vcu * NWAVES + F.wave, NGW = F.G * NWAVES, lane = F.lane;
    for (int qi = gw; qi < M * NH; qi += NGW) {
        const int t = qi >> 4, bh = qi & 15, b = bh >> 3, h = bh & 7;
        const size_t row = (size_t)b * SEQ + t;
        const unsigned qw = *(const GAS unsigned*)(F.Q + row * 1024 + h * 128 + 2 * lane);
        const float q0 = bflo(qw), q1 = bfhi(qw);
        float run = 0.f, o0 = 0.f, o1 = 0.f;
        const bf16* Kp = F.K + (size_t)b * SEQ * 1024 + h * 128 + 2 * lane;
        const bf16* Vp = F.VT + (size_t)(bh * 128 + 2 * lane) * 4096;
        for (int s = t - 1; s >= 0; --s) {
            const unsigned kw = *(const GAS unsigned*)(Kp + (size_t)s * 1024);
            const float z2 = wave_sum(q0 * bflo(kw) + q1 * bfhi(kw));
            const float L = -softplus2(z2);
            const float w = __builtin_amdgcn_exp2f(z2 + L + run);
            run += L;
            const int sp = (s & ~12) | ((s & 4) << 1) | ((s & 8) >> 1);
            o0 += w * bf2f(Vp[sp]); o1 += w * bf2f(Vp[4096 + sp]);
        }
        *(GAS unsigned*)(F.Y + row * 2048 + h * 128 + 2 * lane) = pk2(o0, o1);
        const float ss = wave_sum(o0 * o0 + o1 * o1);
        if (lane == 0) F.SSQA[row * 8 + h] = ss;
    }
}
__device__ __forceinline__ float gelu_tanh(float g) {
    const float u = 0.7978845608028654f * (g + 0.044715f * g * g * g);
    const float e = __builtin_amdgcn_exp2f(-2.0f * 1.4426950408889634f * fabsf(u));
    const float th = (1.0f - e) / (1.0f + e);
    return 0.5f * g * (1.0f + (u < 0.f ? -th : th));
}
__device__ __forceinline__ void p2_lru_gates_naive(Frame& F) {
    LAS float* xc = (LAS float*)(F.lds + RING_OFF);
    float* BT = F.out;
    for (int row = F.vcu; row < M; row += F.G) {
        const int t = row & (SEQ - 1);
#pragma unroll
        for (int j = 0; j < 2; ++j) { const int ch = F.tid + 512 * j; float a = F.conv_b[ch];
#pragma unroll
            for (int k = 0; k < 4; ++k) { const int tt = t - 3 + k; if (tt >= 0) a += F.conv_w[k * LW + ch] * bf2f(F.XL[(size_t)(row - 3 + k) * 1024 + ch]); }
            xc[ch] = a; }
        __syncthreads();
#pragma unroll
        for (int j = 0; j < 2; ++j) { const int ch = F.tid + 512 * j, blk = ch >> 7, d = ch & 127;
            float rr = F.b_rg[ch], ii = F.b_ig[ch];
            const float* wr_ = F.w_rg + blk * 16384 + d; const float* wi_ = F.w_ig + blk * 16384 + d; const LAS float* xb = xc + blk * 128;
            for (int c = 0; c < 128; ++c) { const float xv = xb[c]; rr += xv * wr_[c * 128]; ii += xv * wi_[c * 128]; }
            const float r = 1.0f / (1.0f + expf(-rr)), i = 1.0f / (1.0f + expf(-ii));
            const float lam = F.lam[ch]; const float lsl = -(fmaxf(-lam, 0.f) + log1pf(expf(-fabsf(lam))));
            const float log_a = 8.0f * r * lsl; const float a = expf(log_a); const float mult = sqrtf(-expm1f(2.0f * log_a));
            F.ATMP[(size_t)row * 1024 + ch] = a; BT[(size_t)row * 1024 + ch] = mult * (i * xc[ch]); }
        __syncthreads();
    }
}
__device__ __forceinline__ void p2_lru_scan_naive(Frame& F) {
    const int gt = blockIdx.x * (NWAVES * 64) + F.tid;
    const float* BT = F.out;
    if (gt < BATCH * LW) { const int b = gt >> 10, ch = gt & 1023; float h = 0.f;
        for (int t = 0; t < SEQ; ++t) { const size_t row = (size_t)b * SEQ + t;
            h = F.ATMP[row * 1024 + ch] * h + BT[row * 1024 + ch];
            const float y = h * gelu_tanh(bf2f(F.GL[row * 1024 + ch]));
            F.Y[row * 2048 + 1024 + ch] = (bf16)f2bf(y); } }
}
__device__ __forceinline__ void p2_lru_ssq_naive(Frame& F) {
    const int gw = F.vcu * NWAVES + F.wave, NGW = F.G * NWAVES, lane = F.lane;
    for (int row = gw; row < M; row += NGW) { const GAS v4u* p = (const GAS v4u*)(F.Y + (size_t)row * 2048 + 1024 + 16 * lane);
        const v4u a = p[0], b = p[1]; float s = 0.f;
#pragma unroll
        for (int q = 0; q < 4; ++q) { const float x0 = bflo(a[q]), x1 = bfhi(a[q]), x2 = bflo(b[q]), x3 = bfhi(b[q]); s += (x0 * x0 + x1 * x1) + (x2 * x2 + x3 * x3); }
        s += __shfl_xor(s, 1); s += __shfl_xor(s, 2); s += __shfl_xor(s, 4);
        if ((lane & 7) == 0) F.SSQL[(size_t)row * 8 + (lane >> 3)] = s; }
}

typedef short bf16x8 __attribute__((ext_vector_type(8)));
typedef float f32x16 __attribute__((ext_vector_type(16)));
typedef __bf16 bf16x2_t __attribute__((ext_vector_type(2)));
__device__ __forceinline__ unsigned cvtpk(float lo, float hi) { f32x2 v = {lo, hi}; bf16x2_t b = __builtin_convertvector(v, bf16x2_t); return __builtin_bit_cast(unsigned, b); }
__device__ __forceinline__ void swap32(float v, float& lo, float& hi) {
    float a_ = v, b_ = v;
    asm volatile("s_nop 1\n\tv_permlane32_swap_b32 %0, %1\n\ts_nop 0" : "+v"(a_), "+v"(b_));
    lo = a_; hi = b_;
}
__device__ __forceinline__ void p2_attn_fast(Frame& F) {
    const int lane = F.lane, r32 = lane & 31, hi = lane >> 5;
    for (int item = F.vcu; item < 256; item += F.G) {
        const int bh = item & 15, qb = item >> 4, b = bh >> 3, hd = bh & 7;
        const int t0 = qb * 256 + F.wave * 32;
        const size_t rowq = (size_t)b * SEQ + t0 + r32;
        bf16x8 qf[8];
        { const bf16* qp = F.Q + rowq * 1024 + hd * 128 + 64 * hi;
#pragma unroll
          for (int d0 = 0; d0 < 8; ++d0) qf[d0] = *(const GAS bf16x8*)(qp + 8 * d0); }
        f32x16 o[4];
#pragma unroll
        for (int d0 = 0; d0 < 4; ++d0)
#pragma unroll
            for (int r = 0; r < 16; ++r) o[d0][r] = 0.f;
        float carry = 0.f;
        const bf16* Kb = F.K + (size_t)b * SEQ * 1024 + hd * 128 + 64 * hi;
        const bf16* Vb = F.VT + (size_t)(bh * 128 + r32) * 4096 + 8 * hi;
        const int qabs = t0 + r32;
        for (int kt = (t0 + 31) >> 6; kt >= 0; --kt) {
            const int key0 = kt * 64;
            f32x16 p0, p1;
#pragma unroll
            for (int r = 0; r < 16; ++r) { p0[r] = 0.f; p1[r] = 0.f; }
            { const bf16* k0p = Kb + (size_t)(key0 + r32) * 1024; const bf16* k1p = k0p + 32 * 1024;
#pragma unroll
              for (int d0 = 0; d0 < 8; ++d0) { const bf16x8 a0 = *(const GAS bf16x8*)(k0p + 8 * d0), a1 = *(const GAS bf16x8*)(k1p + 8 * d0);
                  p0 = __builtin_amdgcn_mfma_f32_32x32x16_bf16(a0, qf[d0], p0, 0, 0, 0); p1 = __builtin_amdgcn_mfma_f32_32x32x16_bf16(a1, qf[d0], p1, 0, 0, 0); } }
            const int lim = ((key0 + 63 >= t0) ? (qabs - key0) : 4096) - 4 * hi;
            float c0[16], c1[16], T[8];
#pragma unroll
            for (int r = 0; r < 16; ++r) { const int kc = (r & 3) + 8 * (r >> 2);
                c0[r] = (kc < lim) ? -softplus2(p0[r]) : 0.f; c1[r] = (kc + 32 < lim) ? -softplus2(p1[r]) : 0.f; }
#pragma unroll
            for (int rr = 0; rr < 4; ++rr) {
                c0[4 * rr + 2] += c0[4 * rr + 3]; c0[4 * rr + 1] += c0[4 * rr + 2]; c0[4 * rr] += c0[4 * rr + 1]; T[rr] = c0[4 * rr];
                c1[4 * rr + 2] += c1[4 * rr + 3]; c1[4 * rr + 1] += c1[4 * rr + 2]; c1[4 * rr] += c1[4 * rr + 1]; T[4 + rr] = c1[4 * rr]; }
            float off[8]; float acc = carry;
#pragma unroll
            for (int k = 7; k >= 0; --k) { float tl, th; swap32(T[k], tl, th); const float gh = acc; acc += th; const float gl = acc; acc += tl; off[k] = hi ? gh : gl; }
            carry = acc;
            unsigned pw[16];
#pragma unroll
            for (int r = 0; r < 16; r += 2) { const int kc = (r & 3) + 8 * (r >> 2);
                const float w0 = (kc < lim) ? __builtin_amdgcn_exp2f(p0[r] + c0[r] + off[r >> 2]) : 0.f, w1 = (kc + 1 < lim) ? __builtin_amdgcn_exp2f(p0[r + 1] + c0[r + 1] + off[r >> 2]) : 0.f;
                const float w2 = (kc + 32 < lim) ? __builtin_amdgcn_exp2f(p1[r] + c1[r] + off[4 + (r >> 2)]) : 0.f, w3 = (kc + 33 < lim) ? __builtin_amdgcn_exp2f(p1[r + 1] + c1[r + 1] + off[4 + (r >> 2)]) : 0.f;
                pw[r >> 1] = cvtpk(w0, w1); pw[8 + (r >> 1)] = cvtpk(w2, w3); }
#pragma unroll
            for (int ks = 0; ks < 4; ++ks) {
                const v4u pu = (v4u){pw[4 * ks], pw[4 * ks + 1], pw[4 * ks + 2], pw[4 * ks + 3]}; const bf16x8 pb = __builtin_bit_cast(bf16x8, pu);
#pragma unroll
                for (int d0 = 0; d0 < 4; ++d0) { const bf16x8 va = *(const GAS bf16x8*)(Vb + (size_t)d0 * 32 * 4096 + key0 + 16 * ks);
                    o[d0] = __builtin_amdgcn_mfma_f32_32x32x16_bf16(va, pb, o[d0], 0, 0, 0); } }
            if (__all(carry < -151.0f)) break;
        }
        float ss = 0.f;
        bf16* yp = F.Y + rowq * 2048 + hd * 128 + 4 * hi;
#pragma unroll
        for (int d0 = 0; d0 < 4; ++d0)
#pragma unroll
            for (int rr = 0; rr < 4; ++rr) { const float a = o[d0][4 * rr], b2 = o[d0][4 * rr + 1], c = o[d0][4 * rr + 2], d = o[d0][4 * rr + 3];
                ss += (a * a + b2 * b2) + (c * c + d * d); v2u w; w.x = cvtpk(a, b2); w.y = cvtpk(c, d); *(GAS v2u*)(yp + d0 * 32 + 8 * rr) = w; }
        ss += __shfl_xor(ss, 32);
        if (hi == 0) F.SSQA[rowq * 8 + hd] = ss;
    }
}

constexpr int LR_XCF = 0, LR_XCB = 32768, LR_AS = 51200, LR_BS = 83968, LR_SEG = 116736, LR_LB = 120832, LR_XCB_LD = 136;
__device__ __forceinline__ void p2_lru_fast(Frame& F) {
    const int tid = F.tid, lane = F.lane, r32 = lane & 31, hi = lane >> 5, wave = F.wave;
    LAS float* XCF = (LAS float*)(F.lds + LR_XCF); LAS bf16* XCB = (LAS bf16*)(F.lds + LR_XCB);
    LAS float* AS = (LAS float*)(F.lds + LR_AS); LAS float* BS = (LAS float*)(F.lds + LR_BS);
    LAS float* SEGP = (LAS float*)(F.lds + LR_SEG); LAS float* SEGH = SEGP + 512;
    LAS float* LBP = (LAS float*)(F.lds + LR_LB); LAS float* LBH = LBP + 512;
    gu64* AGG = (gu64*)(F.ws + WS_LAGG);
    for (int it = F.vcu; it < 1024; it += F.G) {
        const int c = it >> 4, b = (it >> 3) & 1, blk = it & 7;
        const int t0 = c * 64; const size_t row0 = (size_t)b * SEQ + t0;
        { const int ch2 = tid & 63, tg = wave; const int chg = blk * 128 + 2 * ch2;
          float x0[11], x1[11];
#pragma unroll
          for (int j = 0; j < 11; ++j) { const int t = t0 + 8 * tg - 3 + j; unsigned w = 0u; if (t >= 0) w = *(const GAS unsigned*)(F.XL + ((size_t)b * SEQ + t) * 1024 + chg); x0[j] = bflo(w); x1[j] = bfhi(w); }
          float w0[4], w1[4];
#pragma unroll
          for (int k = 0; k < 4; ++k) { w0[k] = F.conv_w[k * LW + chg]; w1[k] = F.conv_w[k * LW + chg + 1]; }
          const float cb0 = F.conv_b[chg], cb1 = F.conv_b[chg + 1];
#pragma unroll
          for (int i = 0; i < 8; ++i) { float a0 = cb0, a1 = cb1;
#pragma unroll
              for (int k = 0; k < 4; ++k) { a0 += w0[k] * x0[i + k]; a1 += w1[k] * x1[i + k]; }
              const int tl = 8 * tg + i; *(LAS f32x2*)(XCF + tl * 128 + 2 * ch2) = (f32x2){a0, a1}; *(LAS unsigned*)(XCB + tl * LR_XCB_LD + 2 * ch2) = pk2(a0, a1); } }
        __syncthreads();
        const int tm = wave >> 2, cn = wave & 3; const int chl = 32 * cn + r32, chg = blk * 128 + chl;
        f32x16 aR, aI;
#pragma unroll
        for (int r = 0; r < 16; ++r) { aR[r] = 0.f; aI[r] = 0.f; }
        { const LAS bf16* ap = XCB + (32 * tm + r32) * LR_XCB_LD + 64 * hi; const bf16* rp = F.WRG + blk * 16384 + chl * 128 + 64 * hi; const bf16* ip = F.WIG + blk * 16384 + chl * 128 + 64 * hi;
#pragma unroll
          for (int ks = 0; ks < 8; ++ks) { const bf16x8 a = *(const LAS bf16x8*)(ap + 8 * ks); const bf16x8 br = *(const GAS bf16x8*)(rp + 8 * ks), bi = *(const GAS bf16x8*)(ip + 8 * ks);
              aR = __builtin_amdgcn_mfma_f32_32x32x16_bf16(a, br, aR, 0, 0, 0); aI = __builtin_amdgcn_mfma_f32_32x32x16_bf16(a, bi, aI, 0, 0, 0); } }
        { const float lam = F.lam[chg]; const float cl2 = -8.0f * 1.4426950408889634f * (fmaxf(-lam, 0.f) + log1pf(expf(-fabsf(lam))));
          const float br_ = F.b_rg[chg], bi_ = F.b_ig[chg];
#pragma unroll
          for (int r = 0; r < 16; ++r) { const int tl = 32 * tm + (r & 3) + 8 * (r >> 2) + 4 * hi;
              const float rg = __builtin_amdgcn_rcpf(1.0f + __builtin_amdgcn_exp2f(-1.4426950408889634f * (aR[r] + br_)));
              const float ig = __builtin_amdgcn_rcpf(1.0f + __builtin_amdgcn_exp2f(-1.4426950408889634f * (aI[r] + bi_)));
              const float la2 = cl2 * rg;
              const float a = __builtin_amdgcn_exp2f(la2);
              const float x = la2 * (2.0f * 0.6931471805599453f);
              const float pm1 = x * (1.0f + x * (0.5f + x * (0.16666667f + x * (0.041666668f + x * 0.008333334f))));
              const float om = (x > -0.25f) ? -pm1 : (1.0f - a * a);
              AS[tl * 128 + chl] = a; BS[tl * 128 + chl] = sqrtf(om) * (ig * XCF[tl * 128 + chl]); } }
        __syncthreads();
        const int ch = tid & 127, seg = tid >> 7;
        unsigned short gq[16];
#pragma unroll
        for (int i = 0; i < 16; ++i) gq[i] = F.GL[(row0 + 16 * seg + i) * 1024 + blk * 128 + ch];
        float Pi[16], Hi[16];
        { float P = 1.f, h = 0.f;
#pragma unroll
          for (int i = 0; i < 16; ++i) { const float a = AS[(16 * seg + i) * 128 + ch], bt = BS[(16 * seg + i) * 128 + ch]; P *= a; h = a * h + bt; Pi[i] = P; Hi[i] = h; }
          SEGP[seg * 128 + ch] = P; SEGH[seg * 128 + ch] = h; }
        __syncthreads();
        gu64* agg = AGG + ((size_t)(b * 8 + blk) * 64) * 256;
        if (seg == 0) { float P = 1.f, h = 0.f;
#pragma unroll
            for (int s = 0; s < 4; ++s) { const float ps = SEGP[s * 128 + ch], hs = SEGH[s * 128 + ch]; P *= ps; h = ps * h + hs; }
            __hip_atomic_store(agg + (size_t)c * 256 + ch, (1ull << 32) | __builtin_bit_cast(unsigned, P), RLX_AGENT);
            __hip_atomic_store(agg + (size_t)c * 256 + 128 + ch, (1ull << 32) | __builtin_bit_cast(unsigned, h), RLX_AGENT); }
        { float P = 1.f, h = 0.f; const int lo = 16 * seg, n = (c - lo) < 16 ? (c - lo) : 16;
#pragma unroll 1
          for (int k0 = 0; k0 < n; k0 += 8) { unsigned long long gp[8], gh[8]; unsigned spins = 0; const int nn = (n - k0) < 8 ? (n - k0) : 8;
              for (;;) { bool ok = true;
#pragma unroll
                  for (int k = 0; k < 8; ++k) if (k < nn) { gp[k] = __hip_atomic_load(agg + (size_t)(lo + k0 + k) * 256 + ch, RLX_AGENT); gh[k] = __hip_atomic_load(agg + (size_t)(lo + k0 + k) * 256 + 128 + ch, RLX_AGENT);
                      ok = ok && ((gp[k] >> 32) == 1ull) && ((gh[k] >> 32) == 1ull); }
                  if (ok) break;
                  __builtin_amdgcn_s_sleep(2);
                  if (++spins > (1u << 20)) { if (tid == 0) __hip_atomic_store(F.ctl + CW_TMO, 1u, RLX_AGENT); break; } }
#pragma unroll
              for (int k = 0; k < 8; ++k) if (k < nn) { const float pk = __builtin_bit_cast(float, (unsigned)gp[k]), hk = __builtin_bit_cast(float, (unsigned)gh[k]); P *= pk; h = pk * h + hk; } }
          LBP[seg * 128 + ch] = P; LBH[seg * 128 + ch] = h; }
        __syncthreads();
        float hin = 0.f;
#pragma unroll
        for (int s = 0; s < 4; ++s) hin = LBP[s * 128 + ch] * hin + LBH[s * 128 + ch];
#pragma unroll
        for (int s = 0; s < 3; ++s) if (s < seg) hin = SEGP[s * 128 + ch] * hin + SEGH[s * 128 + ch];
        bf16* yp = F.Y + (row0 + 16 * seg) * 2048 + 1024 + blk * 128 + ch;
#pragma unroll
        for (int i = 0; i < 16; ++i) { const float hv = Hi[i] + Pi[i] * hin; const float y = hv * gelu_tanh(bf2f(gq[i])); yp[(size_t)i * 2048] = (bf16)f2bf(y); AS[(16 * seg + i) * 128 + ch] = y * y; }
        __syncthreads();
        { const int t = tid >> 3, part = tid & 7; const LAS f32x4* p = (const LAS f32x4*)(AS + t * 128 + 16 * part); const f32x4 a = p[0], b4 = p[1], c4 = p[2], d4 = p[3];
          float s = ((a.x + a.y) + (a.z + a.w)) + ((b4.x + b4.y) + (b4.z + b4.w)) + ((c4.x + c4.y) + (c4.z + c4.w)) + ((d4.x + d4.y) + (d4.z + d4.w));
          s += __shfl_xor(s, 1); s += __shfl_xor(s, 2); s += __shfl_xor(s, 4);
          if (part == 0) F.SSQL[(row0 + t) * 8 + blk] = s; }
        __syncthreads();
    }
}

__device__ __forceinline__ void p3b_rows(Frame& F) {
    const int gw = F.vcu * NWAVES + F.wave, NGW = F.G * NWAVES, lane = F.lane;
    for (int row = gw; row < M; row += NGW) {
        const GAS f32x4* mr = (const GAS f32x4*)(F.MBUF + (size_t)row * D) + lane; const GAS f32x4* xr = (const GAS f32x4*)(F.x + (size_t)row * D) + lane;
        f32x4 v[8]; float s = 0.f;
#pragma unroll
        for (int j = 0; j < 8; ++j) { v[j] = mr[64 * j]; s += (v[j].x * v[j].x + v[j].y * v[j].y) + (v[j].z * v[j].z + v[j].w * v[j].w); }
        const float rstd = 1.f / sqrtf(wave_sum(s) * (1.f / D) + RMS_EPS); float s2 = 0.f;
        GAS f32x4* orow = (GAS f32x4*)(F.out + (size_t)row * D) + lane;
#pragma unroll
        for (int j = 0; j < 8; ++j) { const f32x4 gg = ((const GAS f32x4*)F.g_postmix)[64 * j + lane]; v[j] = xr[64 * j] + v[j] * rstd * gg; orow[64 * j] = v[j];
            s2 += (v[j].x * v[j].x + v[j].y * v[j].y) + (v[j].z * v[j].z + v[j].w * v[j].w); }
        const float rstd2 = 1.f / sqrtf(wave_sum(s2) * (1.f / D) + RMS_EPS);
        GAS v2u* o8 = (GAS v2u*)(F.XN + (size_t)row * D) + lane;
#pragma unroll
        for (int j = 0; j < 8; ++j) { const f32x4 gg = ((const GAS f32x4*)F.g_preffn)[64 * j + lane]; v2u w; w.x = pk2(v[j].x * rstd2 * gg.x, v[j].y * rstd2 * gg.y); w.y = pk2(v[j].z * rstd2 * gg.z, v[j].w * rstd2 * gg.w); o8[64 * j] = w; }
    }
}
__device__ __forceinline__ void p5b_rows(Frame& F) {
    const int gw = F.vcu * NWAVES + F.wave, NGW = F.G * NWAVES, lane = F.lane;
    for (int row = gw; row < M; row += NGW) {
        const GAS f32x4* fr_ = (const GAS f32x4*)(F.FBUF + (size_t)row * D) + lane;
        f32x4 v[8]; float s = 0.f;
#pragma unroll
        for (int j = 0; j < 8; ++j) { v[j] = fr_[64 * j]; s += (v[j].x * v[j].x + v[j].y * v[j].y) + (v[j].z * v[j].z + v[j].w * v[j].w); }
        const float rstd = 1.f / sqrtf(wave_sum(s) * (1.f / D) + RMS_EPS);
        GAS f32x4* orow = (GAS f32x4*)(F.out + (size_t)row * D) + lane;
#pragma unroll
        for (int j = 0; j < 8; ++j) { const f32x4 gg = ((const GAS f32x4*)F.g_postffn)[64 * j + lane]; orow[64 * j] = orow[64 * j] + v[j] * rstd * gg; }
    }
}
__device__ __forceinline__ void p3_row_table(Frame& F, int pm) {
    LAS f32x2* RS = (LAS f32x2*)(F.lds + RS_OFF);
    if (F.tid < 256) { const size_t row = (size_t)pm * 256 + F.tid; const GAS f32x4* a = (const GAS f32x4*)(F.SSQA + row * 8); const GAS f32x4* l = (const GAS f32x4*)(F.SSQL + row * 8);
        const f32x4 a0 = a[0], a1 = a[1], l0 = l[0], l1 = l[1];
        const float sa = ((a0.x + a0.y) + (a0.z + a0.w)) + ((a1.x + a1.y) + (a1.z + a1.w)), sl = ((l0.x + l0.y) + (l0.z + l0.w)) + ((l1.x + l1.y) + (l1.z + l1.w));
        const float ra = 1.f / sqrtf(sa * (1.f / AW) + RMS_EPS), rl = 1.f / sqrtf(sl * (1.f / LW) + RMS_EPS);
        RS[F.tid] = (f32x2){ra / rl, rl}; }
    __syncthreads();
}

constexpr int PH_P0 = 0, PH_P1 = 1, PH_P2A = 2, PH_P2B = 3, PH_P2C = 4, PH_P3 = 5, PH_P3B = 6, PH_P4 = 7, PH_P5 = 8, PH_P5B = 9, N_PHASES = 10;
struct Args { const float* in[19]; float* out; unsigned char* ws; int ph_lo, ph_hi, li, pad; };
__global__ void __launch_bounds__(NWAVES * 64, 2) hymba_fwd(Args args) {
    extern __shared__ __attribute__((aligned(16))) unsigned char lds[];
    Frame F;
    F.lds = (LAS unsigned char*)lds;
    F.MISC = (volatile LAS unsigned*)(F.lds + MISC_OFF);
    F.tid = threadIdx.x; F.lane = F.tid & 63; F.wave = __builtin_amdgcn_readfirstlane(F.tid >> 6);
    F.G = gridDim.x; { const int bx = blockIdx.x; F.vcu = (F.G % 8 == 0) ? (bx % 8) * (F.G / 8) + bx / 8 : bx; }
    unsigned char* ws = args.ws; F.ws = ws;
    F.ctl = (gu32*)(ws + WS_CTL);
    F.x = args.in[0]; F.g_premix = args.in[1]; F.g_postmix = args.in[2]; F.g_preffn = args.in[3]; F.g_postffn = args.in[4]; F.w_in = args.in[5]; F.conv_w = args.in[6]; F.conv_b = args.in[7];
    F.w_rg = args.in[8]; F.b_rg = args.in[9]; F.w_ig = args.in[10]; F.b_ig = args.in[11]; F.lam = args.in[12]; F.g_attn = args.in[13]; F.g_lru = args.in[14]; F.w_out = args.in[15];
    F.w_gate = args.in[16]; F.w_up = args.in[17]; F.w_down = args.in[18]; F.out = args.out;
    F.WIN = (bf16*)(ws + WS_WIN); F.WOUT = (bf16*)(ws + WS_WOUT); F.WGU = (bf16*)(ws + WS_WGU); F.WDN = (bf16*)(ws + WS_WDN); F.WRG = (bf16*)(ws + WS_WRG); F.WIG = (bf16*)(ws + WS_WIG);
    F.XN = (bf16*)(ws + WS_XN); F.Q = (bf16*)(ws + WS_Q); F.K = (bf16*)(ws + WS_K); F.VT = (bf16*)(ws + WS_VT); F.XL = (bf16*)(ws + WS_XL); F.GL = (bf16*)(ws + WS_GL); F.Y = (bf16*)(ws + WS_Y); F.H = (bf16*)(ws + WS_H);
    F.SSQA = (float*)(ws + WS_SSQA); F.SSQL = (float*)(ws + WS_SSQL); F.XCH = (float*)(ws + WS_XCH); F.MBUF = (float*)(ws + WS_MBUF); F.FBUF = (float*)(ws + WS_FBUF); F.ATMP = (float*)(ws + WS_ATMP);
    for (int u = F.tid; u < (LDS_BYTES - LDSCTL_OFF) / 4; u += NWAVES * 64) ((LAS unsigned*)(F.lds + LDSCTL_OFF))[u] = 0u;
    __syncthreads();
    const bool one_launch = (MK_N_LAUNCHES == 1);
    XcdBarrier bar; bar.bar = (unsigned*)(F.ctl + CW_BAR); bar.x = 0; bar.st = nullptr;
    if (one_launch) bar = xcd_barrier_post((unsigned*)(F.ctl + CW_BAR), F.MISC + 8);
    const int lo = args.ph_lo, hi = args.ph_hi;
#define IN(k) (lo <= (k) && (k) < hi)
#define SEAM(k) do { if (IN(k) && IN((k) + 1)) xcd_barrier(bar); } while (0)

    if (IN(PH_P0)) { p0_prologue(F); } SEAM(PH_P0);
    if (IN(PH_P1)) {
        pg8::Gemm g{F.XN, F.WIN, M, INW, D}; pg8::StaticOrder S; S.init(M, INW, F.G, (int)blockIdx.x);
        pg8::EpiInProj E{F.Q, F.K, F.VT, F.XL, F.GL};
        pg8::gemm_phase<pg8::EpiInProj, pg8::StaticOrder, true, true>(F.lds + RING_OFF, g, S, E);
    } SEAM(PH_P1);
    #if FAST_LRU
    if (IN(PH_P2A)) { p2_lru_fast(F);
#else
    if (IN(PH_P2A)) { p2_lru_gates_naive(F);
#endif
#if FAST_ATTN
        p2_attn_fast(F); } SEAM(PH_P2A);
#else
        p2_attn_naive(F); } SEAM(PH_P2A);
#endif
#if !FAST_LRU
    if (IN(PH_P2B)) { p2_lru_scan_naive(F); } SEAM(PH_P2B);
    if (IN(PH_P2C)) { p2_lru_ssq_naive(F); } SEAM(PH_P2C);
#else
    SEAM(PH_P2B); SEAM(PH_P2C);
#endif
    if (IN(PH_P3)) {
        pg8::Gemm g{F.Y, F.WOUT, M, D, D}; pg8::StaticOrder S; S.init(M, D, F.G, (int)blockIdx.x);
        pg8::Unit u0; if (S.next(0, u0)) p3_row_table(F, u0.pm); else __syncthreads();
        pg8::EpiOutProjF32 E{F.MBUF, D, F.lds};
        pg8::gemm_phase<pg8::EpiOutProjF32, pg8::StaticOrder, false, true>(F.lds + RING_OFF, g, S, E);
    } SEAM(PH_P3);
    if (IN(PH_P3B)) { p3b_rows(F); } SEAM(PH_P3B);
    if (IN(PH_P4)) {
        pg8::Gemm g{F.XN, F.WGU, M, GUW, D}; pg8::StaticOrder S; S.init(M, GUW, F.G, (int)blockIdx.x);
        pg8::EpiSwiGLU E{F.H};
        pg8::gemm_phase<pg8::EpiSwiGLU, pg8::StaticOrder, true, true>(F.lds + RING_OFF, g, S, E);
    } SEAM(PH_P4);
    if (IN(PH_P5)) {
        pg8::Gemm g{F.H, F.WDN, M, D, FF}; pg8::StaticOrder S; S.init(M, D, F.G, (int)blockIdx.x);
        pg8::EpiF32 E{F.FBUF, D};
        pg8::gemm_phase<pg8::EpiF32, pg8::StaticOrder, false, true>(F.lds + RING_OFF, g, S, E);
    } SEAM(PH_P5);
    if (IN(PH_P5B)) { p5b_rows(F); }
#undef IN
#undef SEAM
}

extern "C" void kernel_launch(void* const* d_in, const int* in_sizes, int n_in, void* d_out, int out_size, void* d_ws, size_t ws_size, hipStream_t stream) {
    static int grid = 0;
    if (grid == 0) {
        if (n_in != 19 || in_sizes[0] != M * D || out_size != M * D || ws_size < WS_END) { fprintf(stderr, "kernel_launch: unexpected shapes (n_in %d, in0 %d, out %d, ws %zu); nothing launched\n", n_in, n_in > 0 ? in_sizes[0] : -1, out_size, ws_size); grid = -1; return; }
        int dev = 0, cus = 0, per_cu = 0;
        if (hipGetDevice(&dev) != hipSuccess || hipDeviceGetAttribute(&cus, hipDeviceAttributeMultiprocessorCount, dev) != hipSuccess) { grid = -1; return; }
        if (hipFuncSetAttribute((const void*)hymba_fwd, hipFuncAttributeMaxDynamicSharedMemorySize, LDS_BYTES) != hipSuccess) { fprintf(stderr, "kernel_launch: hipFuncSetAttribute failed\n"); grid = -1; return; }
        if (hipOccupancyMaxActiveBlocksPerMultiprocessor(&per_cu, (const void*)hymba_fwd, NWAVES * 64, LDS_BYTES) != hipSuccess || per_cu < 1)
            fprintf(stderr, "kernel_launch: note: occupancy query reports %d workgroups per CU\n", per_cu);
        (void)hipGetLastError();
        grid = cus;
    }
    if (grid < 0) return;
    if (hipMemsetAsync((char*)d_ws + WS_CTL, 0, CTL_ZERO_BYTES, stream) != hipSuccess) { fprintf(stderr, "kernel_launch: hipMemsetAsync failed\n"); return; }
    Args a{};
    for (int i = 0; i < 19; ++i) a.in[i] = (const float*)d_in[i];
    a.out = (float*)d_out; a.ws = (unsigned char*)d_ws;
#if MK_N_LAUNCHES == 1
    a.ph_lo = 0; a.ph_hi = N_PHASES; a.li = 0;
    hipLaunchKernelGGL(hymba_fwd, dim3(grid), dim3(NWAVES * 64), LDS_BYTES, stream, a);
#else
    for (int li = 0; li < N_PHASES; ++li) { a.ph_lo = li; a.ph_hi = li + 1; a.li = li;
        hipLaunchKernelGGL(hymba_fwd, dim3(grid), dim3(NWAVES * 64), LDS_BYTES, stream, a); }
#endif
    const hipError_t le = hipPeekAtLastError();
    if (le != hipSuccess) fprintf(stderr, "kernel_launch: launch failed: %s\n", hipGetErrorName(le));
}
```

```cpp
#include <hip/hip_runtime.h>
#include <cstdio>
#include <cstdint>
namespace pg8 {
#define PG8_LAS __attribute__((address_space(3)))
typedef unsigned short bf16_t;
typedef short bf16x8 __attribute__((ext_vector_type(8)));
typedef float f32x4 __attribute__((ext_vector_type(4)));
typedef unsigned u32x4 __attribute__((ext_vector_type(4)));
constexpr int BM = 256, BK = 64, HALF = 128, HTB = HALF * BK * 2  , STAGE_BYTES = 8 * HTB, NXCD = 8, WGM = 8;

__host__ __device__ __forceinline__ int lds_byte(int r, int c) { const int st = (r >> 4) * 2 + (c >> 5), rr = r & 15, cc = c & 31, ob = rr * 64 + cc * 2; return st * 1024 + (ob ^ (((ob >> 9) & 1) << 5)); }
__host__ __device__ __forceinline__ void stage_rc(int b, int& R, int& C) { const int st = b / 1024, sb = b % 1024, swz = sb ^ (((sb >> 9) & 1) << 5); R = (st >> 1) * 16 + swz / 64; C = (st & 1) * 32 + (swz % 64) / 2; }
__host__ __device__ __forceinline__ int perm32(int rho) { const int n = rho >> 4, i = rho & 15; return 8 * (i >> 2) + 4 * n + (i & 3); }

struct Unit { int pm, pn; };
struct Gemm { const bf16_t* A; const bf16_t* Bt; int M, N, K; };

struct StaticOrder {
    int nM, nN, nwg, G, c, wgm;
    __host__ __device__ void init(int M, int N, int G_, int c_, int wgm_ = WGM) { nM = M / BM; nN = N / BM; nwg = nM * nN; G = G_; c = c_; wgm = wgm_; }
    __host__ __device__ bool next(int i, Unit& u) const {
        const long L = (long)i * G + c; if (L >= nwg) return false;
        int wgid = (int)L; { const int q = nwg / NXCD, r = nwg % NXCD, xcd = wgid % NXCD, off = wgid / NXCD; wgid = (xcd < r ? xcd * (q + 1) : r * (q + 1) + (xcd - r) * q) + off; }
        const int nig = wgm * nN, gid = wgid / nig, fm = gid * wgm, gsz = (nM - fm) < wgm ? (nM - fm) : wgm;
        u.pm = fm + ((wgid % nig) % gsz); u.pn = (wgid % nig) / gsz; return true;
    }
    __device__ __forceinline__ void a_ready(const Unit&) const {}
    __device__ __forceinline__ void done(const Unit&) const {}
};

__device__ __forceinline__ unsigned cvt_pk_bf16(float lo, float hi) { unsigned r; asm volatile("v_cvt_pk_bf16_f32 %0, %1, %2" : "=v"(r) : "v"(lo), "v"(hi)); return r; }
typedef float f32x2 __attribute__((ext_vector_type(2)));
__device__ __forceinline__ f32x2 gelu_pk(f32x2 v) {
    const f32x2 av = __builtin_elementwise_abs(v), d = av * 0.2316418882f + 1.0f;
    f32x2 t; t.x = __builtin_amdgcn_rcpf(d.x); t.y = __builtin_amdgcn_rcpf(d.y);
    f32x2 q = t * 0.5307027145f + (-0.7265760135f); q = q * t + 0.7107068705f; q = q * t + (-0.142248368f); q = q * t + 0.127414796f; q = q * t;
    const f32x2 s = (v * v) * (-0.72134752044f);
    f32x2 e; e.x = __builtin_amdgcn_exp2f(s.x); e.y = __builtin_amdgcn_exp2f(s.y);
    const f32x2 m = v * (q * e), r = v - m;
    f32x2 o; o.x = v.x < 0.f ? m.x : r.x; o.y = v.y < 0.f ? m.y : r.y; return o;
}

template <int ACT  > struct EpiBf16 {
    static constexpr bool PERM = true, AFTER_DRAIN = false; static_assert(ACT == 0 || ACT == 1, "EpiBf16: ACT is 0 (none) or 1 (gelu_pk)");
    bf16_t* O; int ldc; const float* bias; int split_cols; size_t split_stride; float scale0;
    __device__ __forceinline__ void operator()(const f32x4 (&acc)[2][2][4][2], const Unit& u, int wr, int wc, int fr, int fq) const {
        const int row0 = u.pm * BM + wr * 64 + fr; int colt = u.pn * BM; bf16_t* base = O;
        float sc = 1.f; if (split_cols) { const int t = colt / split_cols; base += (size_t)t * split_stride; colt -= t * split_cols; if (t == 0) sc = scale0; }
        const int col0 = colt + wc * 32 + 8 * fq, bcol0 = u.pn * BM + wc * 32 + 8 * fq;
        f32x4 bv[2][2];
#pragma unroll
        for (int bj = 0; bj < 2; ++bj)
#pragma unroll
            for (int n = 0; n < 2; ++n) bv[bj][n] = bias ? *(const f32x4*)(bias + bcol0 + bj * HALF + 4 * n) : (f32x4){0.f, 0.f, 0.f, 0.f};
#pragma unroll
        for (int ai = 0; ai < 2; ++ai)
#pragma unroll
            for (int m = 0; m < 4; ++m) { bf16_t* rowp = base + (size_t)(row0 + ai * HALF + m * 16) * ldc + col0;
#pragma unroll
                for (int bj = 0; bj < 2; ++bj) { f32x4 v0 = acc[ai][bj][m][0] + bv[bj][0], v1 = acc[ai][bj][m][1] + bv[bj][1];
                    if (ACT == 1) { f32x2 a = gelu_pk((f32x2){v0[0], v0[1]}), b = gelu_pk((f32x2){v0[2], v0[3]}), c = gelu_pk((f32x2){v1[0], v1[1]}), d = gelu_pk((f32x2){v1[2], v1[3]});
                        v0 = (f32x4){a.x, a.y, b.x, b.y}; v1 = (f32x4){c.x, c.y, d.x, d.y}; }
                    v0 = v0 * sc; v1 = v1 * sc; u32x4 w; w.x = cvt_pk_bf16(v0[0], v0[1]); w.y = cvt_pk_bf16(v0[2], v0[3]); w.z = cvt_pk_bf16(v1[0], v1[1]); w.w = cvt_pk_bf16(v1[2], v1[3]);
                    *(u32x4*)(rowp + bj * HALF) = w; } }
    }
};

struct PanelStats {
    unsigned* xbuf;
    unsigned* cnt;
    unsigned* tmo;
    int ntn; float eps;
    unsigned code;
    __device__ __forceinline__ bool run(const f32x4 (&v)[2][2][4][2], const Unit& u, int wr, int wc, int fr, int fq, PG8_LAS unsigned char* lds, int wid, int lane) const {
        typedef float f32x2v __attribute__((ext_vector_type(2)));
        PG8_LAS f32x2v* P = (PG8_LAS f32x2v*)lds;
        PG8_LAS f32x2v* S = (PG8_LAS f32x2v*)(lds + 8192);
        PG8_LAS unsigned* flag = (PG8_LAS unsigned*)(lds + 8192 + 2048);
#pragma unroll
        for (int ai = 0; ai < 2; ++ai)
#pragma unroll
            for (int m = 0; m < 4; ++m) {
                float s = 0.f;
#pragma unroll
                for (int bj = 0; bj < 2; ++bj)
#pragma unroll
                    for (int n = 0; n < 2; ++n) { const f32x4 x = v[ai][bj][m][n]; s += (x[0] + x[1]) + (x[2] + x[3]); }
                s += __shfl_xor(s, 16); s += __shfl_xor(s, 32);
                const float mw = s * (1.0f / 64.0f); float q = 0.f;
#pragma unroll
                for (int bj = 0; bj < 2; ++bj)
#pragma unroll
                    for (int n = 0; n < 2; ++n) { const f32x4 d = v[ai][bj][m][n] - mw; q += (d[0] * d[0] + d[1] * d[1]) + (d[2] * d[2] + d[3] * d[3]); }
                q += __shfl_xor(q, 16); q += __shfl_xor(q, 32);
                if (fq == 0) P[(ai * HALF + wr * 64 + m * 16 + fr) * 4 + wc] = (f32x2v){mw, q};
            }
        asm volatile("s_waitcnt lgkmcnt(0)" ::: "memory"); __builtin_amdgcn_s_barrier(); asm volatile("" ::: "memory");
#if defined(BROKEN_EXCHANGE_NO_WAIT)
#warning BROKEN CONTROL BUILD: the row-statistics exchange does not wait; results are wrong by design
        if (blockIdx.x >= 64) { const long long t0_ = clock64(); while (clock64() - t0_ < 60000) __builtin_amdgcn_s_sleep(8); }
#endif
        const int row = wid * 32 + (lane & 31);
        if (lane < 32) {
            const f32x2v a = P[row * 4 + 0], b = P[row * 4 + 1], c = P[row * 4 + 2], d = P[row * 4 + 3];
            const float mt = (a.x + b.x + c.x + d.x) * 0.25f;
            const float da = a.x - mt, db = b.x - mt, dc = c.x - mt, dd = d.x - mt;
            const float m2 = (a.y + b.y) + (c.y + d.y) + 64.0f * ((da * da + db * db) + (dc * dc + dd * dd));
            unsigned long long* slot = (unsigned long long*)xbuf + ((size_t)(u.pm * BM + row) * 4 + u.pn);
            __hip_atomic_store(slot, ((unsigned long long)__float_as_uint(m2) << 32) | __float_as_uint(mt), __ATOMIC_RELAXED, __HIP_MEMORY_SCOPE_AGENT);
        }
        asm volatile("s_waitcnt vmcnt(0)" ::: "memory");
        if (lane == 0) __hip_atomic_fetch_add(cnt + 64 * u.pm, 1u, __ATOMIC_RELAXED, __HIP_MEMORY_SCOPE_AGENT);
        if (wid == 0) {
            bool dead = false; const unsigned long long t0 = __builtin_amdgcn_s_memrealtime(); const unsigned want = 8u * (unsigned)ntn;
            for (;;) {
#if defined(BROKEN_EXCHANGE_NO_WAIT)
                break;
#endif
                if ((unsigned)__builtin_amdgcn_readfirstlane(__hip_atomic_load(cnt + 64 * u.pm, __ATOMIC_RELAXED, __HIP_MEMORY_SCOPE_AGENT)) >= want) break;
                if (__builtin_amdgcn_s_memrealtime() - t0 > 2000000ull) {
                    if (lane == 0) { unsigned expect = 0u; __hip_atomic_compare_exchange_strong(tmo + 1, &expect, code | (unsigned)(u.pm & 0xff), __ATOMIC_RELAXED, __ATOMIC_RELAXED, __HIP_MEMORY_SCOPE_AGENT);
                                     __hip_atomic_store(tmo, 1u, __ATOMIC_RELAXED, __HIP_MEMORY_SCOPE_AGENT); }
                    dead = true; break; }
                __builtin_amdgcn_s_sleep(2);
            }
            __builtin_amdgcn_fence(__ATOMIC_ACQUIRE, "agent");
            if (lane == 0) flag[0] = dead ? 1u : 0u;
        }
        asm volatile("s_waitcnt vmcnt(0) lgkmcnt(0)" ::: "memory"); __builtin_amdgcn_s_barrier(); asm volatile("" ::: "memory");
        const bool bad = flag[0] != 0u;
        if (lane < 32) {
            const unsigned long long* slot = (const unsigned long long*)xbuf + (size_t)(u.pm * BM + row) * 4; float mt[4], m2[4]; float ms = 0.f;
#pragma unroll
            for (int t = 0; t < 4; ++t) { if (t < ntn) { const unsigned long long w = __hip_atomic_load(slot + t, __ATOMIC_RELAXED, __HIP_MEMORY_SCOPE_AGENT); mt[t] = __uint_as_float((unsigned)w); m2[t] = __uint_as_float((unsigned)(w >> 32)); } else { mt[t] = 0.f; m2[t] = 0.f; } ms += mt[t]; }
            const float mean = ms / (float)ntn; float q = 0.f;
#pragma unroll
            for (int t = 0; t < 4; ++t) if (t < ntn) { const float dm = mt[t] - mean; q += m2[t] + 256.0f * dm * dm; }
            S[row] = (f32x2v){mean, 1.0f / sqrtf(q / (256.0f * (float)ntn) + eps)};
        }
        asm volatile("s_waitcnt lgkmcnt(0)" ::: "memory"); __builtin_amdgcn_s_barrier(); asm volatile("" ::: "memory");
        return bad;
    }
};
struct EpiLnRes {
    static constexpr bool PERM = false, AFTER_DRAIN = true;
    const float* base; float* out; int ldc; const float* bias; PanelStats st; unsigned poison;
    __device__ __forceinline__ void fused(f32x4 (&acc)[2][2][4][2], const Unit& u, int wr, int wc, int fr, int fq, PG8_LAS unsigned char* lds, int wid, int lane) const {
        typedef float f32x2v __attribute__((ext_vector_type(2)));
        const PG8_LAS f32x2v* S = (const PG8_LAS f32x2v*)(lds + 8192);
        const int col0 = u.pn * BM + wc * 32 + 4 * fq;
#pragma unroll
        for (int bj = 0; bj < 2; ++bj)
#pragma unroll
            for (int n = 0; n < 2; ++n) { const f32x4 bv = bias ? *(const f32x4*)(bias + col0 + bj * HALF + n * 16) : (f32x4){0.f, 0.f, 0.f, 0.f};
#pragma unroll
                for (int ai = 0; ai < 2; ++ai)
#pragma unroll
                    for (int m = 0; m < 4; ++m) acc[ai][bj][m][n] += bv; }
        f32x4 pre[4][2][2];
#pragma unroll
        for (int m = 0; m < 4; ++m) { const size_t off = (size_t)(u.pm * BM + wr * 64 + m * 16 + fr) * ldc + col0;
#pragma unroll
            for (int bj = 0; bj < 2; ++bj)
#pragma unroll
                for (int n = 0; n < 2; ++n) pre[m][bj][n] = *(const f32x4*)(base + off + bj * HALF + n * 16); }
        const bool bad = st.run(acc, u, wr, wc, fr, fq, lds, wid, lane) || poison != 0u;
        const float qnan = __builtin_nanf("");
#pragma unroll
        for (int ai = 0; ai < 2; ++ai)
#pragma unroll
            for (int m = 0; m < 4; ++m) { const int r = ai * HALF + wr * 64 + m * 16 + fr; const f32x2v sr = S[r]; const size_t off = (size_t)(u.pm * BM + r) * ldc + col0;
#pragma unroll
                for (int bj = 0; bj < 2; ++bj)
#pragma unroll
                    for (int n = 0; n < 2; ++n) { const f32x4 bs = ai == 0 ? pre[m][bj][n] : *(const f32x4*)(base + off + bj * HALF + n * 16); f32x4 o = bs + (acc[ai][bj][m][n] - sr.x) * sr.y;
                        if (bad) o = (f32x4){qnan, qnan, qnan, qnan}; *(f32x4*)(out + off + bj * HALF + n * 16) = o; }
                if (m & 1) asm volatile("" ::: "memory"); }
    }
};
struct EpiLnResLn {
    static constexpr bool PERM = false, AFTER_DRAIN = true;
    const float* base; float* out; bf16_t* xn; int ldc; const float* bias; PanelStats st1, st2; unsigned poison;
    __device__ __forceinline__ void fused(f32x4 (&acc)[2][2][4][2], const Unit& u, int wr, int wc, int fr, int fq, PG8_LAS unsigned char* lds, int wid, int lane) const {
        typedef float f32x2v __attribute__((ext_vector_type(2))); typedef unsigned u32x2v __attribute__((ext_vector_type(2)));
        const PG8_LAS f32x2v* S = (const PG8_LAS f32x2v*)(lds + 8192);
        const int col0 = u.pn * BM + wc * 32 + 4 * fq;
#pragma unroll
        for (int bj = 0; bj < 2; ++bj)
#pragma unroll
            for (int n = 0; n < 2; ++n) { const f32x4 bv = bias ? *(const f32x4*)(bias + col0 + bj * HALF + n * 16) : (f32x4){0.f, 0.f, 0.f, 0.f};
#pragma unroll
                for (int ai = 0; ai < 2; ++ai)
#pragma unroll
                    for (int m = 0; m < 4; ++m) acc[ai][bj][m][n] += bv; }
        bool bad = st1.run(acc, u, wr, wc, fr, fq, lds, wid, lane) || poison != 0u;
        const float qnan = __builtin_nanf("");
#pragma unroll
        for (int ai = 0; ai < 2; ++ai)
#pragma unroll
            for (int m = 0; m < 4; ++m) { const int r = ai * HALF + wr * 64 + m * 16 + fr; const f32x2v sr = S[r]; const size_t off = (size_t)(u.pm * BM + r) * ldc + col0;
#pragma unroll
                for (int bj = 0; bj < 2; ++bj)
#pragma unroll
                    for (int n = 0; n < 2; ++n) { const f32x4 bs = *(const f32x4*)(base + off + bj * HALF + n * 16); acc[ai][bj][m][n] = bs + (acc[ai][bj][m][n] - sr.x) * sr.y; }
                asm volatile("" : "+v"(acc[ai][0][m][0]), "+v"(acc[ai][0][m][1]), "+v"(acc[ai][1][m][0]), "+v"(acc[ai][1][m][1]));
                if (m & 1) asm volatile("" ::: "memory"); }
        const bool bad1 = bad;
        bad = st2.run(acc, u, wr, wc, fr, fq, lds, wid, lane) || bad;
#pragma unroll
        for (int ai = 0; ai < 2; ++ai)
#pragma unroll
            for (int m = 0; m < 4; ++m) { const int r = ai * HALF + wr * 64 + m * 16 + fr; const f32x2v sr = S[r]; const size_t off = (size_t)(u.pm * BM + r) * ldc + col0;
#pragma unroll
                for (int bj = 0; bj < 2; ++bj)
#pragma unroll
                    for (int n = 0; n < 2; ++n) { const f32x4 x1 = acc[ai][bj][m][n]; *(f32x4*)(out + off + bj * HALF + n * 16) = bad1 ? (f32x4){qnan, qnan, qnan, qnan} : x1;
                        const f32x4 o = (x1 - sr.x) * sr.y; u32x2v w; w.x = cvt_pk_bf16(o[0], o[1]); w.y = cvt_pk_bf16(o[2], o[3]);
                        if (bad) { w.x = 0x7fc07fc0u; w.y = 0x7fc07fc0u; } *(u32x2v*)(xn + off + bj * HALF + n * 16) = w; }
                asm volatile("" ::: "memory"); }
    }
};

template <class Epi, class Sched, bool ALIGN_EPI = false, bool SP2 = false>
__device__ __forceinline__ void gemm_phase(PG8_LAS unsigned char* lds, const Gemm g, const Sched& S, const Epi& E) {
    const int tid = threadIdx.x, wid = __builtin_amdgcn_readfirstlane(tid >> 6), lane = tid & 63, wr = wid >> 2, wc = wid & 3, fr = lane & 15, fq = lane >> 4;
    const int K = g.K, nt = K / BK;
    unsigned voffA[2], voffB[2];
#pragma unroll
    for (int i = 0; i < 2; ++i) { int R, C; stage_rc(tid * 16 + i * 8192, R, C); const int Rb = Epi::PERM ? ((R & ~31) + perm32(R & 31)) : R;
        voffA[i] = (unsigned)(R * K + C) * 2u; voffB[i] = (unsigned)(Rb * K + C) * 2u; }
    const size_t kstep = (size_t)(BK * 2);
    const size_t hstep = (size_t)HALF * K * 2;
    const size_t tstep = 2 * hstep;
    const unsigned ldsw = (unsigned)wid * 1024u;
    const int aoff = lds_byte(wr * 64 + fr, fq * 8), boff = lds_byte(wc * 32 + fr, fq * 8);
#ifndef PG8_B_AUX
#define PG8_B_AUX 0
#endif
#define PG8_SA(b, h) (((b) * 2 + (h)) * HTB)
#define PG8_SB(b, h) ((4 + (b) * 2 + (h)) * HTB)
#define PG8_STAGE(bufoff, gbase, voff) do { _Pragma("unroll") for (int _i = 0; _i < 2; ++_i) \
        __builtin_amdgcn_global_load_lds((const unsigned*)((const char*)(gbase) + (voff)[_i]), (PG8_LAS unsigned*)(lds + (bufoff) + ldsw + _i * 8192), 16, 0, ((bufoff) >= 4 * HTB) ? PG8_B_AUX : 0); } while (0)
#define PG8_LDA(dst, b, h) do { _Pragma("unroll") for (int m = 0; m < 4; ++m) _Pragma("unroll") for (int k = 0; k < 2; ++k) dst[m][k] = *(const PG8_LAS bf16x8*)(lds + PG8_SA(b, h) + aoff + m * 2048 + k * 1024); } while (0)
#define PG8_LDB(dst, b, h) do { _Pragma("unroll") for (int n = 0; n < 2; ++n) _Pragma("unroll") for (int k = 0; k < 2; ++k) dst[n][k] = *(const PG8_LAS bf16x8*)(lds + PG8_SB(b, h) + boff + n * 2048 + k * 1024); } while (0)
#define PG8_MMA(ai, bj, At, Bt) do { __builtin_amdgcn_s_setprio(1); _Pragma("unroll") for (int m = 0; m < 4; ++m) _Pragma("unroll") for (int n = 0; n < 2; ++n) _Pragma("unroll") for (int k = 0; k < 2; ++k) \
        acc[ai][bj][m][n] = __builtin_amdgcn_mfma_f32_16x16x32_bf16(Bt[n][k], At[m][k], acc[ai][bj][m][n], 0, 0, 0); __builtin_amdgcn_s_setprio(0); } while (0)
#define PG8_WAIT_V(n) asm volatile("s_waitcnt vmcnt(" #n ")" ::: "memory")
#define PG8_WAIT_L(n) asm volatile("s_waitcnt lgkmcnt(" #n ")" ::: "memory")
#define PG8_BAR __builtin_amdgcn_s_barrier()
#define PG8_SCHED __builtin_amdgcn_sched_barrier(0)
    Unit cur, nxt; int ui = 0;
    if (!S.next(0, cur)) return;
    f32x4 acc[2][2][4][2];
#pragma unroll
    for (int a = 0; a < 2; ++a)
#pragma unroll
        for (int b = 0; b < 2; ++b)
#pragma unroll
            for (int m = 0; m < 4; ++m)
#pragma unroll
                for (int n = 0; n < 2; ++n) acc[a][b][m][n] = (f32x4){0.f, 0.f, 0.f, 0.f};
    bf16x8 At[4][2], B0[2][2], B1[2][2];
    const char* cA = (const char*)g.A + (size_t)cur.pm * tstep; const char* cB = (const char*)g.Bt + (size_t)cur.pn * tstep;
    S.a_ready(cur);
    if constexpr (SP2) {
        PG8_STAGE(PG8_SB(0, 0), cB, voffB); PG8_STAGE(PG8_SB(0, 1), cB + hstep, voffB); PG8_STAGE(PG8_SA(0, 0), cA, voffA); PG8_STAGE(PG8_SA(0, 1), cA + hstep, voffA);
        if (wr == 1) PG8_BAR;
        PG8_WAIT_V(2); PG8_BAR;
        PG8_STAGE(PG8_SB(1, 0), cB + kstep, voffB); PG8_STAGE(PG8_SA(1, 0), cA + kstep, voffA); PG8_STAGE(PG8_SB(1, 1), cB + hstep + kstep, voffB);
        PG8_WAIT_V(6); PG8_BAR;
    } else {
        PG8_STAGE(PG8_SB(0, 0), cB, voffB); PG8_STAGE(PG8_SA(0, 0), cA, voffA); PG8_STAGE(PG8_SB(0, 1), cB + hstep, voffB); PG8_STAGE(PG8_SA(0, 1), cA + hstep, voffA);
        if (wr == 1) PG8_BAR;
        PG8_WAIT_V(4); PG8_BAR;
        PG8_STAGE(PG8_SB(1, 0), cB + kstep, voffB); PG8_STAGE(PG8_SA(1, 0), cA + kstep, voffA); PG8_STAGE(PG8_SB(1, 1), cB + hstep + kstep, voffB);
        PG8_WAIT_V(6); PG8_BAR;
    }
    for (;;) {
        const bool has_next = S.next(ui + 1, nxt);
        const char* nA = has_next ? (const char*)g.A + (size_t)nxt.pm * tstep : cA; const char* nB = has_next ? (const char*)g.Bt + (size_t)nxt.pn * tstep : cB;
        for (int t = 0; t < nt; t += 2) {
            if constexpr (Epi::MIDK) { if (t == (nt >> 1)) E.midk(acc, cur, wr, wc, fr, fq, lds); }
            const bool last = (t == nt - 2);
            const char* a1 = cA + (size_t)(t + 1) * kstep;
            const char* a2 = last ? nA : cA + (size_t)(t + 2) * kstep; const char* b2 = last ? nB : cB + (size_t)(t + 2) * kstep;
            const char* a3 = a2 + kstep; const char* b3 = b2 + kstep;
            if (last && has_next) S.a_ready(nxt);
            if constexpr (SP2) {
            PG8_LDB(B0, 0, 0); PG8_LDB(B1, 0, 1); PG8_SCHED; PG8_LDA(At, 0, 0); PG8_STAGE(PG8_SA(1, 1), a1 + hstep, voffA);
            PG8_WAIT_V(8); PG8_WAIT_L(0); PG8_BAR; PG8_MMA(0, 0, At, B0); PG8_MMA(0, 1, At, B1); PG8_BAR; PG8_SCHED;
            PG8_LDA(At, 0, 1); PG8_STAGE(PG8_SB(0, 0), b2, voffB); PG8_STAGE(PG8_SB(0, 1), b2 + hstep, voffB); PG8_STAGE(PG8_SA(0, 0), a2, voffA);
            PG8_WAIT_V(8); PG8_WAIT_L(0); PG8_BAR; PG8_MMA(1, 0, At, B0); PG8_MMA(1, 1, At, B1); PG8_BAR; PG8_SCHED;
            PG8_LDB(B0, 1, 0); PG8_LDB(B1, 1, 1); PG8_SCHED; PG8_LDA(At, 1, 0); PG8_STAGE(PG8_SA(0, 1), a2 + hstep, voffA);
            PG8_WAIT_V(8); PG8_WAIT_L(0); PG8_BAR; PG8_MMA(0, 0, At, B0); PG8_MMA(0, 1, At, B1); PG8_BAR; PG8_SCHED;
            PG8_LDA(At, 1, 1); PG8_STAGE(PG8_SB(1, 0), b3, voffB); PG8_STAGE(PG8_SB(1, 1), b3 + hstep, voffB); PG8_STAGE(PG8_SA(1, 0), a3, voffA);
            PG8_WAIT_V(8); PG8_WAIT_L(0); PG8_BAR; PG8_MMA(1, 0, At, B0); PG8_MMA(1, 1, At, B1); PG8_BAR; PG8_SCHED;
            } else {
            PG8_LDB(B0, 0, 0); PG8_SCHED; PG8_LDA(At, 0, 0); PG8_STAGE(PG8_SA(1, 1), a1 + hstep, voffA);
            PG8_WAIT_L(8); PG8_BAR; PG8_WAIT_L(0); PG8_MMA(0, 0, At, B0); PG8_BAR; PG8_SCHED;
            PG8_LDB(B1, 0, 1); PG8_STAGE(PG8_SB(0, 0), b2, voffB);
            PG8_BAR; PG8_WAIT_L(0); PG8_MMA(0, 1, At, B1); PG8_BAR;
            PG8_LDA(At, 0, 1); PG8_STAGE(PG8_SA(0, 0), a2, voffA);
            PG8_BAR; PG8_WAIT_L(0); PG8_MMA(1, 0, At, B0); PG8_BAR; PG8_SCHED;
            PG8_STAGE(PG8_SB(0, 1), b2 + hstep, voffB);
            PG8_WAIT_V(6); PG8_BAR; PG8_MMA(1, 1, At, B1); PG8_BAR;
            PG8_LDB(B0, 1, 0); PG8_SCHED; PG8_LDA(At, 1, 0); PG8_STAGE(PG8_SA(0, 1), a2 + hstep, voffA);
            PG8_WAIT_L(8); PG8_BAR; PG8_WAIT_L(0); PG8_MMA(0, 0, At, B0); PG8_BAR; PG8_SCHED;
            PG8_LDB(B1, 1, 1); PG8_STAGE(PG8_SB(1, 0), b3, voffB);
            PG8_BAR; PG8_WAIT_L(0); PG8_MMA(0, 1, At, B1); PG8_BAR;
            PG8_LDA(At, 1, 1); PG8_STAGE(PG8_SA(1, 0), a3, voffA);
            PG8_BAR; PG8_WAIT_L(0); PG8_MMA(1, 0, At, B0); PG8_BAR; PG8_SCHED;
            PG8_STAGE(PG8_SB(1, 1), b3 + hstep, voffB);
            PG8_WAIT_V(6); PG8_BAR; PG8_MMA(1, 1, At, B1); PG8_BAR;
            }
        }
        if constexpr (ALIGN_EPI) { if (wr == 0) PG8_BAR; }
        if constexpr (!Epi::AFTER_DRAIN) { E(acc, cur, wr, wc, fr, fq); S.done(cur); }
        if (!has_next) break;
#pragma unroll
        for (int a = 0; a < 2; ++a)
#pragma unroll
            for (int b = 0; b < 2; ++b)
#pragma unroll
                for (int m = 0; m < 4; ++m)
#pragma unroll
                    for (int n = 0; n < 2; ++n) acc[a][b][m][n] = (f32x4){0.f, 0.f, 0.f, 0.f};
        cur = nxt; cA = nA; cB = nB; ++ui;
        if constexpr (ALIGN_EPI) { if (wr == 1) PG8_BAR; }
    }
    PG8_WAIT_V(0);
    if constexpr (!ALIGN_EPI) { if (wr == 0) PG8_BAR; }
    PG8_BAR;
    if constexpr (Epi::AFTER_DRAIN) { E.fused(acc, cur, wr, wc, fr, fq, lds, wid, lane); S.done(cur); }
#undef PG8_SA
#undef PG8_SB
#undef PG8_STAGE
#undef PG8_LDA
#undef PG8_LDB
#undef PG8_MMA
#undef PG8_WAIT_V
#undef PG8_WAIT_L
#undef PG8_BAR
#undef PG8_SCHED
}
}

constexpr int NWAVES = 8;
constexpr int BATCH = 2, SEQ = 4096, D = 2048, M = BATCH * SEQ;
constexpr int AW = 1024, LW = 1024, HD = 128, NH = 8, NLB = 8, LBS = 128, FF = 5632, INW = 5120, GUW = 2 * FF;
constexpr float RMS_EPS = 1e-6f;
constexpr float C2 = 1.4426950408889634f * 0.08838834764831845f;

#ifndef WGM_P1
#define WGM_P1 4
#endif
#ifndef WGM_P3
#define WGM_P3 4
#endif
#ifndef WGM_P4
#define WGM_P4 4
#endif
#ifndef WGM_P5
#define WGM_P5 4
#endif
#ifndef MK_N_LAUNCHES
#define MK_N_LAUNCHES 1
#endif

constexpr size_t MiB = 1u << 20;
constexpr size_t WS_CTL = 0, CTL_ZERO_BYTES = 1 * MiB, WS_XG = 256 * 1024;
constexpr size_t WS_WIN = 2 * MiB;
constexpr size_t WS_WOUT = 22 * MiB;
constexpr size_t WS_WGU = 30 * MiB;
constexpr size_t WS_WDN = 74 * MiB;
constexpr size_t WS_WRG = 96 * MiB;
constexpr size_t WS_WIG = WS_WRG + 256 * 1024;
constexpr size_t WS_SSQA = 97 * MiB;
constexpr size_t WS_SSQL = WS_SSQA + 256 * 1024;
constexpr size_t WS_XCH = 98 * MiB;
constexpr size_t WS_XN = 100 * MiB;
constexpr size_t WS_Q = 132 * MiB, WS_K = 148 * MiB, WS_VT = 164 * MiB, WS_XL = 180 * MiB, WS_GL = 196 * MiB;
constexpr size_t WS_Y = 212 * MiB;
constexpr size_t WS_H = 132 * MiB;
constexpr size_t WS_END = 256 * MiB;
constexpr size_t WS_LAGG = 244 * MiB;

constexpr int CW_TMO = 0, CW_CODE = 1, CW_BAR = 4096;

constexpr int RING_OFF = 0, RING_BYTES = 131072;
constexpr int LDSCTL_OFF = RING_BYTES, MISC_OFF = LDSCTL_OFF + 320;
constexpr int RS_OFF = RING_BYTES + 1024;
constexpr int LDS_BYTES = 147456;

#define GAS __attribute__((address_space(1)))
#define LAS __attribute__((address_space(3)))
typedef unsigned short bf16;
typedef unsigned v4u __attribute__((ext_vector_type(4)));
typedef unsigned v2u __attribute__((ext_vector_type(2)));
typedef float f32x4 __attribute__((ext_vector_type(4)));
typedef float f32x2 __attribute__((ext_vector_type(2)));
typedef GAS unsigned gu32;
typedef GAS unsigned long long gu64;
#define RLX_AGENT __ATOMIC_RELAXED, __HIP_MEMORY_SCOPE_AGENT
#define LDS_WAIT() asm volatile("s_waitcnt lgkmcnt(0)" ::: "memory")
#define VM_WAIT() asm volatile("s_waitcnt vmcnt(0)" ::: "memory")
typedef __bf16 bf16x2_t __attribute__((ext_vector_type(2)));
__device__ __forceinline__ unsigned pk2(float lo, float hi) { f32x2 v = {lo, hi}; bf16x2_t b = __builtin_convertvector(v, bf16x2_t); return __builtin_bit_cast(unsigned, b); }
__device__ __forceinline__ unsigned f2bf(float f) { return pk2(f, 0.f) & 0xffffu; }
__device__ __forceinline__ float bf2f(unsigned h) { return __builtin_bit_cast(float, h << 16); }
__device__ __forceinline__ float bflo(unsigned w) { return __builtin_bit_cast(float, w << 16); }
__device__ __forceinline__ float bfhi(unsigned w) { return __builtin_bit_cast(float, w & 0xffff0000u); }

#define XB_TMO      128
#define XB_XCNT(j)  (256  + 64 * (j))
#define XB_XSUB(j)  (1280 + 64 * (j))
#define XB_XGEN(j)  (2304 + 64 * (j))
#define XB_TOP      3328
#define XB_TOPGEN   3392
#define XB_FLAG     3392
#define XCD_BAR_WORDS 3456
#define XB_SPIN_CAP (1u << 18)
__device__ __forceinline__ unsigned xb_ld(unsigned* p)              { return __hip_atomic_load(p, __ATOMIC_RELAXED, __HIP_MEMORY_SCOPE_AGENT); }
__device__ __forceinline__ unsigned xb_add(unsigned* p, unsigned v) { return __hip_atomic_fetch_add(p, v, __ATOMIC_RELAXED, __HIP_MEMORY_SCOPE_AGENT); }
__device__ __forceinline__ unsigned xb_xcc_id() { return (unsigned)__builtin_amdgcn_s_getreg((3 << 11) | 20) & 0xFu; }
#define XB_SPIN(cond, bar) do { unsigned _sp = 0; while (cond) { __builtin_amdgcn_s_sleep(1); \
    if ((++_sp & 255u) == 0u) { if (xb_ld(&(bar)[XB_TMO])) break; if (_sp > XB_SPIN_CAP) { atomicAdd(&(bar)[XB_TMO], 1u); break; } } } } while (0)
struct XcdBarrier { unsigned* bar; unsigned x; volatile LAS unsigned* st; };
__device__ __forceinline__ XcdBarrier xcd_barrier_post(unsigned* bar, volatile LAS unsigned* st) {
    XcdBarrier b; b.bar = bar; b.x = xb_xcc_id(); b.st = st;
    if (threadIdx.x == 0) (void)xb_add(&bar[XB_XCNT(b.x)], 1u);
    return b;
}
__device__ __forceinline__ void xcd_barrier_complete(unsigned* bar, unsigned x, unsigned& nloc, unsigned& xmask) {
    const unsigned G = gridDim.x * gridDim.y * gridDim.z;
    unsigned sum, msk, mine, sp = 0u;
    for (;;) {
        sum = 0u; msk = 0u; mine = 0u;
#pragma unroll
        for (unsigned j = 0; j < 16; ++j) { const unsigned c = xb_ld(&bar[XB_XCNT(j)]); sum += c; msk |= (c > 0u) ? (1u << j) : 0u; mine = (j == x) ? c : mine; }
        if (sum == G) break;
        __builtin_amdgcn_s_sleep(1);
        if ((++sp & 255u) == 0u) { if (xb_ld(&bar[XB_TMO])) break; if (sp > XB_SPIN_CAP) { atomicAdd(&bar[XB_TMO], 1u); break; } }
    }
    nloc = mine > 0u ? mine : 1u; xmask = msk > 0u ? msk : (1u << x);
}
__device__ __forceinline__ void xcd_barrier(const XcdBarrier& b, unsigned gen) {
    if (threadIdx.x == 0u && b.st[0] == 0u) { unsigned n_, m_; xcd_barrier_complete(b.bar, b.x, n_, m_); b.st[1] = m_; b.st[0] = n_; }
    asm volatile("s_waitcnt vmcnt(0)" ::: "memory");
    __syncthreads();
    if (threadIdx.x < 64u) {
        unsigned* bar = b.bar;
        const unsigned lane = threadIdx.x;
        __builtin_amdgcn_s_waitcnt(0);
        unsigned nloc = b.st[0];
        if (nloc == 0u) {
            if (lane == 0u) { unsigned n_, m_; xcd_barrier_complete(bar, b.x, n_, m_); b.st[1] = m_; b.st[0] = n_; }
            asm volatile("s_waitcnt lgkmcnt(0)" ::: "memory");
            nloc = b.st[0];
        }
        const unsigned xmask = b.st[1];
        unsigned old = 0u;
        if (lane == 0u) old = xb_add(&bar[XB_XSUB(b.x)], 1u);
        old = (unsigned)__builtin_amdgcn_readfirstlane((int)old);
        if (old + 1u == (gen + 1u) * nloc) {
            __builtin_amdgcn_fence(__ATOMIC_RELEASE, "agent");
            asm volatile("s_waitcnt vmcnt(0)" ::: "memory");
        }
        const bool need = lane < 16u && ((xmask >> lane) & 1u) != 0u;
        if (old + 1u == (gen + 1u) * nloc) { if (need) (void)xb_add(&bar[XB_XGEN(lane) + b.x], 1u); }
        unsigned sp = 0u;
        for (;;) {
            unsigned v = 0xffffffffu;
            if (need) v = xb_ld(&bar[XB_XGEN(b.x) + lane]);
            if (__builtin_amdgcn_ballot_w64(v <= gen) == 0ull) break;

            if ((++sp & 255u) == 0u) { if (xb_ld(&bar[XB_TMO])) break; if (sp > XB_SPIN_CAP) { if (lane == 0u) atomicAdd(&bar[XB_TMO], 1u); break; } }
        }
        __builtin_amdgcn_fence(__ATOMIC_ACQUIRE, "agent");
        asm volatile("s_waitcnt vmcnt(0)" ::: "memory");
    }
    __syncthreads();
}

__device__ __forceinline__ void swap32(float v, float& lo, float& hi);
namespace pg8 {
struct EpiInProj {
    static constexpr bool PERM = true, AFTER_DRAIN = false, MIDK = false;
    bf16_t *Q, *K, *VT, *XL, *GL;
    __device__ __forceinline__ void operator()(const f32x4 (&acc)[2][2][4][2], const Unit& u, int wr, int wc, int fr, int fq) const {
        const int t = u.pn >> 2, colt = (u.pn & 3) * BM;
        const int row0 = u.pm * BM + wr * 64 + fr;
        if (t >= 3) {
            bf16_t* base = (t == 3) ? XL : GL;
            const int col0 = colt + wc * 32 + 8 * fq;
#pragma unroll
            for (int ai = 0; ai < 2; ++ai)
#pragma unroll
                for (int m = 0; m < 4; ++m) { bf16_t* rowp = base + (size_t)(row0 + ai * HALF + m * 16) * 1024 + col0;
#pragma unroll
                    for (int bj = 0; bj < 2; ++bj) { const f32x4 v0 = acc[ai][bj][m][0], v1 = acc[ai][bj][m][1];
                        u32x4 w; w.x = cvt_pk_bf16(v0[0], v0[1]); w.y = cvt_pk_bf16(v0[2], v0[3]); w.z = cvt_pk_bf16(v1[0], v1[1]); w.w = cvt_pk_bf16(v1[2], v1[3]);
                        *(u32x4*)(rowp + bj * HALF) = w; } }
        } else if (t != 2) {
            bf16_t* base = (t == 0) ? Q : K; const float sc = (t == 0) ? C2 : 1.f;
            const int d0 = wc * 32 + 8 * fq;
#pragma unroll
            for (int ai = 0; ai < 2; ++ai)
#pragma unroll
                for (int m = 0; m < 4; ++m) { const int row = row0 + ai * HALF + m * 16; const int bb = row >> 12, s = row & 4095;
#pragma unroll
                    for (int bj = 0; bj < 2; ++bj) { const int hd = 2 * (u.pn & 3) + bj; const f32x4 v0 = acc[ai][bj][m][0] * sc, v1 = acc[ai][bj][m][1] * sc;
                        u32x4 w; w.x = cvt_pk_bf16(v0[0], v0[1]); w.y = cvt_pk_bf16(v0[2], v0[3]); w.z = cvt_pk_bf16(v1[0], v1[1]); w.w = cvt_pk_bf16(v1[2], v1[3]);
                        *(u32x4*)(base + ((size_t)(bb * 8 + hd) * 4096 + s) * 128 + d0) = w; } }
        } else {
#pragma unroll
            for (int ai = 0; ai < 2; ++ai)
#pragma unroll
                for (int m = 0; m < 4; ++m) { const int row = row0 + ai * HALF + m * 16; const int bb = row >> 12, s = row & 4095;
                    const int kp = ((s & 63) & ~12) | ((s & 4) << 1) | ((s & 8) >> 1); const int tile = s >> 6;
#pragma unroll
                    for (int bj = 0; bj < 2; ++bj) { const int hd = 2 * (u.pn & 3) + bj;
#pragma unroll
                        for (int n = 0; n < 2; ++n)
#pragma unroll
                            for (int i = 0; i < 4; ++i) { const int d = wc * 32 + 8 * fq + 4 * n + i;
                                VT[(((size_t)(bb * 8 + hd) * 64 + tile) * 128 + d) * 64 + kp] = (bf16_t)(cvt_pk_bf16(acc[ai][bj][m][n][i], 0.f) & 0xffffu); } } }
        }
    }
};

struct PanelSsq {
    unsigned* xg; unsigned* cnt; unsigned* tmo; unsigned code;
    __device__ __forceinline__ bool run(const f32x4 (&v)[2][2][4][2], const Unit& u, int wr, int wc, int fr, int fq, PG8_LAS unsigned char* lds, int wid, int lane, float inv_n, float eps) const {
        PG8_LAS float* P = (PG8_LAS float*)lds;
        PG8_LAS float* S = (PG8_LAS float*)(lds + 8192);
        PG8_LAS unsigned* flag = (PG8_LAS unsigned*)(lds + 8192 + 2048);
#pragma unroll
        for (int ai = 0; ai < 2; ++ai)
#pragma unroll
            for (int m = 0; m < 4; ++m) { float s = 0.f;
#pragma unroll
                for (int bj = 0; bj < 2; ++bj)
#pragma unroll
                    for (int n = 0; n < 2; ++n) { const f32x4 x = v[ai][bj][m][n]; s += (x[0] * x[0] + x[1] * x[1]) + (x[2] * x[2] + x[3] * x[3]); }
                s += __builtin_bit_cast(float, __builtin_amdgcn_ds_swizzle(__builtin_bit_cast(int, s), 0x401F)); { float lo_, hi_; ::swap32(s, lo_, hi_); s = lo_ + hi_; }
                if (fq == 0) P[(ai * HALF + wr * 64 + m * 16 + fr) * 4 + wc] = s; }
        asm volatile("s_waitcnt lgkmcnt(0)" ::: "memory"); __builtin_amdgcn_s_barrier(); asm volatile("" ::: "memory");
        const int row = wid * 32 + (lane & 31);
        if (lane < 32) { const f32x4 p = *(const PG8_LAS f32x4*)(P + row * 4); const float t = (p[0] + p[1]) + (p[2] + p[3]);
            __hip_atomic_store(xg + ((size_t)(u.pm * BM + row) * 8 + u.pn), 0x80000000u | __builtin_bit_cast(unsigned, t), __ATOMIC_RELAXED, __HIP_MEMORY_SCOPE_AGENT); }
        bool bad = false;
        { unsigned* slot = xg + (size_t)(u.pm * BM + row) * 8 + 4 * (lane >> 5); float q = 0.f; unsigned sp = 0u;
            __builtin_amdgcn_s_sleep(64);
            for (;;) { unsigned w[4]; unsigned landed = 0x80000000u;
#pragma unroll
                for (int t = 0; t < 4; ++t) w[t] = __hip_atomic_load(slot + t, __ATOMIC_RELAXED, __HIP_MEMORY_SCOPE_AGENT);
#pragma unroll
                for (int t = 0; t < 4; ++t) landed &= w[t];
                if (__builtin_amdgcn_ballot_w64(landed == 0u) == 0ull || bad) { float h = 0.f;
#pragma unroll
                    for (int t = 0; t < 4; ++t) h += __builtin_bit_cast(float, w[t] & 0x7fffffffu);
                    { float lo_, hi_; ::swap32(h, lo_, hi_); q = lo_ + hi_; }
                    break; }
                if (++sp > (1u << 16)) { if (lane == 0) { unsigned expect = 0u; __hip_atomic_compare_exchange_strong(tmo + 1, &expect, code | 0x80u | (unsigned)(u.pm & 0x7f), __ATOMIC_RELAXED, __ATOMIC_RELAXED, __HIP_MEMORY_SCOPE_AGENT);
                                                          __hip_atomic_store(tmo, 1u, __ATOMIC_RELAXED, __HIP_MEMORY_SCOPE_AGENT); }
                    bad = true; break; }
                __builtin_amdgcn_s_sleep(1); }
            if (lane < 32) S[row] = 1.0f / sqrtf(q * inv_n + eps); }
        asm volatile("s_waitcnt lgkmcnt(0)" ::: "memory"); __builtin_amdgcn_s_barrier(); asm volatile("" ::: "memory");
        return bad;
    }
};

struct EpiOutNorm2 {
    static constexpr bool PERM = true, AFTER_DRAIN = true, MIDK = true;
    const float* x; bf16_t* x1b; float* xss; const float* g_post; PanelSsq st1; PG8_LAS unsigned char* ldsb;
    __device__ __forceinline__ void midk(f32x4 (&acc)[2][2][4][2], const Unit& u, int wr, int wc, int fr, int fq, PG8_LAS unsigned char* lds) const {
        const PG8_LAS f32x2* RS = (const PG8_LAS f32x2*)(ldsb + ::RS_OFF);
#pragma unroll
        for (int ai = 0; ai < 2; ++ai)
#pragma unroll
            for (int m = 0; m < 4; ++m) { const float f = RS[ai * HALF + wr * 64 + m * 16 + fr].x;
#pragma unroll
                for (int bj = 0; bj < 2; ++bj)
#pragma unroll
                    for (int n = 0; n < 2; ++n) acc[ai][bj][m][n] *= f; }
    }
    __device__ __forceinline__ void fused(f32x4 (&acc)[2][2][4][2], const Unit& u, int wr, int wc, int fr, int fq, PG8_LAS unsigned char* lds, int wid, int lane) const {
        typedef unsigned u32x2v __attribute__((ext_vector_type(2)));
        const PG8_LAS f32x2* RS = (const PG8_LAS f32x2*)(ldsb + ::RS_OFF);
        const PG8_LAS float* S = (const PG8_LAS float*)(lds + 8192);
        PG8_LAS float* P = (PG8_LAS float*)lds;
        const int col0 = u.pn * BM + wc * 32 + 8 * fq;
#pragma unroll
        for (int ai = 0; ai < 2; ++ai)
#pragma unroll
            for (int m = 0; m < 4; ++m) { const float f = RS[ai * HALF + wr * 64 + m * 16 + fr].y;
#pragma unroll
                for (int bj = 0; bj < 2; ++bj)
#pragma unroll
                    for (int n = 0; n < 2; ++n) acc[ai][bj][m][n] *= f; }
        f32x4 pre[4][2][2];
#pragma unroll
        for (int m = 0; m < 4; ++m) { const size_t off = (size_t)(u.pm * BM + wr * 64 + m * 16 + fr) * 2048 + col0;
#pragma unroll
            for (int bj = 0; bj < 2; ++bj)
#pragma unroll
                for (int n = 0; n < 2; ++n) pre[m][bj][n] = __builtin_nontemporal_load((const f32x4*)(x + off + bj * HALF + 4 * n)); }
        const bool bad = st1.run(acc, u, wr, wc, fr, fq, lds, wid, lane, 1.0f / 2048.0f, ::RMS_EPS);
        f32x4 gp[2][2];
#pragma unroll
        for (int bj = 0; bj < 2; ++bj)
#pragma unroll
            for (int n = 0; n < 2; ++n) gp[bj][n] = *(const f32x4*)(g_post + col0 + bj * HALF + 4 * n);
#pragma unroll
        for (int ai = 0; ai < 2; ++ai)
#pragma unroll
            for (int m = 0; m < 4; ++m) { const int r = ai * HALF + wr * 64 + m * 16 + fr; const float sr = S[r]; const size_t off = (size_t)(u.pm * BM + r) * 2048 + col0; float s = 0.f;
#pragma unroll
                for (int bj = 0; bj < 2; ++bj) { f32x4 x1[2];
#pragma unroll
                    for (int n = 0; n < 2; ++n) { const f32x4 bs = ai == 0 ? pre[m][bj][n] : __builtin_nontemporal_load((const f32x4*)(x + off + bj * HALF + 4 * n)); x1[n] = bs + acc[ai][bj][m][n] * sr * gp[bj][n];
                        if (bad) { const float qn = __builtin_nanf(""); x1[n] = (f32x4){qn, qn, qn, qn}; }
                        s += (x1[n][0] * x1[n][0] + x1[n][1] * x1[n][1]) + (x1[n][2] * x1[n][2] + x1[n][3] * x1[n][3]); }
                    u32x4 w; w.x = cvt_pk_bf16(x1[0][0], x1[0][1]); w.y = cvt_pk_bf16(x1[0][2], x1[0][3]); w.z = cvt_pk_bf16(x1[1][0], x1[1][1]); w.w = cvt_pk_bf16(x1[1][2], x1[1][3]);
                    *(u32x4*)(x1b + off + bj * HALF) = w; }
                s += __builtin_bit_cast(float, __builtin_amdgcn_ds_swizzle(__builtin_bit_cast(int, s), 0x401F)); { float lo_, hi_; ::swap32(s, lo_, hi_); s = lo_ + hi_; }
                if (fq == 0) P[r * 4 + wc] = s;
                if (m & 1) asm volatile("" ::: "memory"); }
        asm volatile("s_waitcnt lgkmcnt(0)" ::: "memory"); __builtin_amdgcn_s_barrier(); asm volatile("" ::: "memory");
        if (lane < 32) { const int row = wid * 32 + lane; const f32x4 p = *(const PG8_LAS f32x4*)(P + row * 4); xss[(size_t)(u.pm * BM + row) * 8 + u.pn] = (p[0] + p[1]) + (p[2] + p[3]); }
    }
};
struct EpiSwiGLU2 {
    static constexpr bool PERM = true, AFTER_DRAIN = false, MIDK = false;
    bf16_t* H; PG8_LAS unsigned char* ldsb; const float* xss; int table_pm;
    __device__ __forceinline__ void operator()(const f32x4 (&acc)[2][2][4][2], const Unit& u, int wr, int wc, int fr, int fq) const {
        const PG8_LAS float* RT = (const PG8_LAS float*)(ldsb + ::RS_OFF);
        const int row0 = u.pm * BM + wr * 64 + fr, col0 = u.pn * HALF + wc * 32 + 8 * fq;
        float rsv[8];
        if (u.pm == table_pm) {
#pragma unroll
            for (int j = 0; j < 8; ++j) rsv[j] = RT[wr * 64 + fr + (j >> 2) * HALF + (j & 3) * 16]; }
        else {
#pragma unroll
            for (int j = 0; j < 8; ++j) { const int r = wr * 64 + fr + (j >> 2) * HALF + (j & 3) * 16; const f32x4* q = (const f32x4*)(xss + (size_t)(u.pm * BM + r) * 8); const f32x4 a = q[0], b = q[1];
                rsv[j] = 1.0f / sqrtf((((a[0] + a[1]) + (a[2] + a[3])) + ((b[0] + b[1]) + (b[2] + b[3]))) * (1.0f / 2048.0f) + ::RMS_EPS); } }
#pragma unroll
        for (int ai = 0; ai < 2; ++ai)
#pragma unroll
            for (int m = 0; m < 4; ++m) { const float rs = rsv[ai * 4 + m];
                bf16_t* rowp = H + (size_t)(row0 + ai * HALF + m * 16) * FF + col0;
                const float irs2 = __builtin_amdgcn_rcpf(rs * rs), rsn = -1.4426950408889634f * rs;
                float h[8];
#pragma unroll
                for (int n = 0; n < 2; ++n)
#pragma unroll
                    for (int i = 0; i < 4; ++i) { const float ag = acc[ai][0][m][n][i], au = acc[ai][1][m][n][i];
                        const float e = __builtin_amdgcn_exp2f(ag * rsn);
                        const float rr = __builtin_amdgcn_rcpf(__builtin_fmaf(e, irs2, irs2));
                        float nn; asm("v_mul_f32_e32 %0, %1, %2" : "=v"(nn) : "v"(ag), "v"(au));
                        h[4 * n + i] = nn * rr; }
                u32x4 w; w.x = cvt_pk_bf16(h[0], h[1]); w.y = cvt_pk_bf16(h[2], h[3]); w.z = cvt_pk_bf16(h[4], h[5]); w.w = cvt_pk_bf16(h[6], h[7]);
                *(u32x4*)rowp = w; }
    }
};
struct EpiDownNorm2 {
    static constexpr bool PERM = true, AFTER_DRAIN = true, MIDK = false;
    float* out; const bf16_t* x1b; const float* g; PanelSsq st;
    __device__ __forceinline__ void fused(f32x4 (&acc)[2][2][4][2], const Unit& u, int wr, int wc, int fr, int fq, PG8_LAS unsigned char* lds, int wid, int lane) const {
        const PG8_LAS float* S = (const PG8_LAS float*)(lds + 8192);
        const int col0 = u.pn * BM + wc * 32 + 8 * fq;
        u32x4 pre[2][4][2];
#pragma unroll
        for (int ai = 0; ai < 2; ++ai)
#pragma unroll
            for (int m = 0; m < 4; ++m) { const size_t off = (size_t)(u.pm * BM + ai * HALF + wr * 64 + m * 16 + fr) * 2048 + col0;
#pragma unroll
                for (int bj = 0; bj < 2; ++bj) pre[ai][m][bj] = __builtin_nontemporal_load((const u32x4*)(x1b + off + bj * HALF)); }
        const bool bad = st.run(acc, u, wr, wc, fr, fq, lds, wid, lane, 1.0f / 2048.0f, ::RMS_EPS);
        const float qnan = __builtin_nanf("");
        f32x4 gp[2][2];
#pragma unroll
        for (int bj = 0; bj < 2; ++bj)
#pragma unroll
            for (int n = 0; n < 2; ++n) gp[bj][n] = *(const f32x4*)(g + col0 + bj * HALF + 4 * n);
#pragma unroll
        for (int ai = 0; ai < 2; ++ai)
#pragma unroll
            for (int m = 0; m < 4; ++m) { const int r = ai * HALF + wr * 64 + m * 16 + fr; const float sr = S[r]; const size_t off = (size_t)(u.pm * BM + r) * 2048 + col0;
#pragma unroll
                for (int bj = 0; bj < 2; ++bj) { const u32x4 pw = pre[ai][m][bj];
#pragma unroll
                    for (int n = 0; n < 2; ++n) { const unsigned lo = n ? pw.z : pw.x, hi_ = n ? pw.w : pw.y;
                        const f32x4 bs = (f32x4){__builtin_bit_cast(float, lo << 16), __builtin_bit_cast(float, lo & 0xffff0000u), __builtin_bit_cast(float, hi_ << 16), __builtin_bit_cast(float, hi_ & 0xffff0000u)};
                        f32x4 o = bs + acc[ai][bj][m][n] * sr * gp[bj][n]; if (bad) o = (f32x4){qnan, qnan, qnan, qnan}; *(f32x4*)(out + off + bj * HALF + 4 * n) = o; } } }
    }
};
}

struct Frame {
    LAS unsigned char* lds;
    volatile LAS unsigned* MISC;
    gu32* ctl;
    int tid, lane, wave, vcu, G;
    const float* x; float* out;
    const float *g_premix, *g_postmix, *g_preffn, *g_postffn, *w_in, *conv_w, *conv_b, *w_rg, *b_rg, *w_ig, *b_ig, *lam, *g_attn, *g_lru, *w_out, *w_gate, *w_up, *w_down;
    bf16 *WIN, *WOUT, *WGU, *WDN, *WRG, *WIG;
    bf16 *XN, *Q, *K, *VT, *XL, *GL, *Y, *H;
    float *SSQA, *SSQL, *XCH;
    unsigned char* ws;
};

#define DPP_ADD(x, ctrl) ((x) + __builtin_bit_cast(float, __builtin_amdgcn_update_dpp(0, __builtin_bit_cast(int, (x)), (ctrl), 0xF, 0xF, true)))
__device__ __forceinline__ float sum8(float x) { x = DPP_ADD(x, 0xB1); x = DPP_ADD(x, 0x4E); x = DPP_ADD(x, 0x141); return x; }
__device__ __forceinline__ void swap32(float v, float& lo, float& hi);
__device__ __forceinline__ float wave_sum(float v) {
    v = sum8(v); v = DPP_ADD(v, 0x140);
    v += __builtin_bit_cast(float, __builtin_amdgcn_ds_swizzle(__builtin_bit_cast(int, v), 0x401F));
    float lo, hi; swap32(v, lo, hi); return lo + hi;
}

struct CvtItem { const float* W; int ldw; bf16* WT; int ldt; int trow0; const float* ks; int k0, n0; };
__device__ __forceinline__ void cvt_load(const CvtItem& I, float (&v)[32], int lane) {
#pragma unroll
    for (int i = 0; i < 32; ++i) { const int kk = 2 * i + (lane >> 5); v[i] = __builtin_nontemporal_load(I.W + (size_t)(I.k0 + kk) * I.ldw + I.n0 + (lane & 31)); }
}
__device__ __forceinline__ void cvt_store(const CvtItem& I, const float (&v)[32], LAS float* scr, int lane) {
#pragma unroll
    for (int i = 0; i < 32; ++i) { const int kk = 2 * i + (lane >> 5); scr[kk * 33 + (lane & 31)] = v[i]; }
    LDS_WAIT(); asm volatile("" ::: "memory");
    const int c = lane & 7;
    float ks[8];
#pragma unroll
    for (int q = 0; q < 8; ++q) ks[q] = I.ks ? I.ks[8 * c + q] : 1.f;
#pragma unroll
    for (int j = 0; j < 4; ++j) { const int n = (lane >> 3) + 8 * j; const LAS float* s = scr + (8 * c) * 33 + n;
        v4u o; o.x = pk2(s[0 * 33] * ks[0], s[1 * 33] * ks[1]); o.y = pk2(s[2 * 33] * ks[2], s[3 * 33] * ks[3]); o.z = pk2(s[4 * 33] * ks[4], s[5 * 33] * ks[5]); o.w = pk2(s[6 * 33] * ks[6], s[7 * 33] * ks[7]);
        *(GAS v4u*)(I.WT + (size_t)(I.trow0 + n) * I.ldt + I.k0 + 8 * c) = o; }
    LDS_WAIT(); asm volatile("" ::: "memory");
}
#define CVT_PIPELINE(DECODE, NITEMS_, gw_, NGW_) do { \
    float va_[32], vb_[32]; CvtItem ia_, ib_; int it_ = (gw_); bool hasA_ = it_ < (NITEMS_); \
    if (hasA_) { ia_ = DECODE(F, it_); cvt_load(ia_, va_, F.lane); } \
    while (hasA_) { \
        const int itB_ = it_ + (NGW_); const bool hasB_ = itB_ < (NITEMS_); if (hasB_) { ib_ = DECODE(F, itB_); cvt_load(ib_, vb_, F.lane); } \
        cvt_store(ia_, va_, scr, F.lane); \
        if (!hasB_) break; \
        const int itA_ = itB_ + (NGW_); hasA_ = itA_ < (NITEMS_); if (hasA_) { ia_ = DECODE(F, itA_); cvt_load(ia_, va_, F.lane); } \
        cvt_store(ib_, vb_, scr, F.lane); \
        it_ = itA_; } } while (0)
struct CvtSet { f32x4 v[8]; f32x4 ka, kb; };
template <bool KS> __device__ __forceinline__ void cvt_issue(const CvtItem& I, CvtSet& R, int lane) {
    const float* p = I.W + (size_t)(I.k0 + (lane >> 3)) * I.ldw + I.n0 + 4 * (lane & 7); const size_t st = (size_t)8 * I.ldw;
#pragma unroll
    for (int i = 0; i < 8; ++i) asm volatile("global_load_dwordx4 %0, %1, off nt" : "=v"(R.v[i]) : "v"(p + i * st) : "memory");
    if (KS) { const float* q = I.ks + 8 * (lane & 7);
        asm volatile("global_load_dwordx4 %0, %1, off" : "=v"(R.ka) : "v"(q) : "memory"); asm volatile("global_load_dwordx4 %0, %1, off" : "=v"(R.kb) : "v"(q + 4) : "memory"); }
}
#define CVT_LANDED(R, N) asm volatile("s_waitcnt vmcnt(" #N ")" : "+v"(R.v[0]), "+v"(R.v[1]), "+v"(R.v[2]), "+v"(R.v[3]), "+v"(R.v[4]), "+v"(R.v[5]), "+v"(R.v[6]), "+v"(R.v[7]), "+v"(R.ka), "+v"(R.kb) :: "memory")
template <bool KS> __device__ __forceinline__ void cvt_emit(const CvtItem& I, const CvtSet& R, LAS float* scr, int lane) {
#pragma unroll
    for (int i = 0; i < 8; ++i) { LAS float* d = scr + (8 * i + (lane >> 3)) * 33 + 4 * (lane & 7); d[0] = R.v[i].x; d[1] = R.v[i].y; d[2] = R.v[i].z; d[3] = R.v[i].w; }
    LDS_WAIT(); asm volatile("" ::: "memory");
    const int c = lane & 7;
    float ks[8];
#pragma unroll
    for (int q = 0; q < 4; ++q) { ks[q] = KS ? R.ka[q] : 1.f; ks[4 + q] = KS ? R.kb[q] : 1.f; }
#pragma unroll
    for (int j = 0; j < 4; ++j) { const int n = (lane >> 3) + 8 * j; const LAS float* s = scr + (8 * c) * 33 + n;
        v4u o; o.x = pk2(s[0 * 33] * ks[0], s[1 * 33] * ks[1]); o.y = pk2(s[2 * 33] * ks[2], s[3 * 33] * ks[3]); o.z = pk2(s[4 * 33] * ks[4], s[5 * 33] * ks[5]); o.w = pk2(s[6 * 33] * ks[6], s[7 * 33] * ks[7]);
        *(GAS v4u*)(I.WT + (size_t)(I.trow0 + n) * I.ldt + I.k0 + 8 * c) = o; }
    LDS_WAIT(); asm volatile("" ::: "memory");
}
#define CVT_RUN(KS, DECODE, first_, hi_, NGW_, W1, W2, W3) do { \
    const int f_ = (first_), h_ = (hi_), g_ = (NGW_); \
    if (f_ < h_) { const int n_ = (h_ - f_ + g_ - 1) / g_; int j_ = 0; \
        CvtSet A_, B_, C_; A_.ka = A_.kb = B_.ka = B_.kb = C_.ka = C_.kb = (f32x4){0.f, 0.f, 0.f, 0.f}; CvtItem ia_, ib_, ic_; \
        if (n_ >= 5) { \
            ia_ = DECODE(F, f_); cvt_issue<KS>(ia_, A_, F.lane); ib_ = DECODE(F, f_ + g_); cvt_issue<KS>(ib_, B_, F.lane); \
            ic_ = DECODE(F, f_ + 2 * g_); cvt_issue<KS>(ic_, C_, F.lane); CVT_LANDED(A_, W1); cvt_emit<KS>(ia_, A_, scr, F.lane); \
            ia_ = DECODE(F, f_ + 3 * g_); cvt_issue<KS>(ia_, A_, F.lane); CVT_LANDED(B_, W2); cvt_emit<KS>(ib_, B_, scr, F.lane); \
            ib_ = DECODE(F, f_ + 4 * g_); cvt_issue<KS>(ib_, B_, F.lane); CVT_LANDED(C_, W3); cvt_emit<KS>(ic_, C_, scr, F.lane); \
            j_ = 3; \
            while (j_ + 4 < n_) { \
                ic_ = DECODE(F, f_ + (j_ + 2) * g_); cvt_issue<KS>(ic_, C_, F.lane); CVT_LANDED(A_, W3); cvt_emit<KS>(ia_, A_, scr, F.lane); \
                ia_ = DECODE(F, f_ + (j_ + 3) * g_); cvt_issue<KS>(ia_, A_, F.lane); CVT_LANDED(B_, W3); cvt_emit<KS>(ib_, B_, scr, F.lane); \
                ib_ = DECODE(F, f_ + (j_ + 4) * g_); cvt_issue<KS>(ib_, B_, F.lane); CVT_LANDED(C_, W3); cvt_emit<KS>(ic_, C_, scr, F.lane); \
                j_ += 3; } \
            CVT_LANDED(A_, 0); CVT_LANDED(B_, 0); cvt_emit<KS>(ia_, A_, scr, F.lane); cvt_emit<KS>(ib_, B_, scr, F.lane); j_ += 2; }     \
        for (; j_ < n_; ++j_) { ia_ = DECODE(F, f_ + j_ * g_); cvt_issue<KS>(ia_, A_, F.lane); CVT_LANDED(A_, 0); cvt_emit<KS>(ia_, A_, scr, F.lane); } } } while (0)
#define CVT_FEW(DECODE, first_, hi_, NGW_) do { \
    const int f_ = (first_), h_ = (hi_), g_ = (NGW_); \
    if (f_ < h_) { const int n_ = (h_ - f_ + g_ - 1) / g_; \
        CvtSet A_, B_, C_; A_.ka = A_.kb = B_.ka = B_.kb = C_.ka = C_.kb = (f32x4){0.f, 0.f, 0.f, 0.f}; CvtItem ia_, ib_, ic_; \
          \
        if (n_ == 2) { \
            ia_ = DECODE(F, f_); cvt_issue<false>(ia_, A_, F.lane); ib_ = DECODE(F, f_ + g_); cvt_issue<false>(ib_, B_, F.lane); \
            CVT_LANDED(A_, 8); cvt_emit<false>(ia_, A_, scr, F.lane); CVT_LANDED(B_, 0); cvt_emit<false>(ib_, B_, scr, F.lane); } \
        else if (n_ == 3) { \
            ia_ = DECODE(F, f_); cvt_issue<false>(ia_, A_, F.lane); ib_ = DECODE(F, f_ + g_); cvt_issue<false>(ib_, B_, F.lane); ic_ = DECODE(F, f_ + 2 * g_); cvt_issue<false>(ic_, C_, F.lane); \
            CVT_LANDED(A_, 16); cvt_emit<false>(ia_, A_, scr, F.lane); CVT_LANDED(B_, 12); cvt_emit<false>(ib_, B_, scr, F.lane); CVT_LANDED(C_, 0); cvt_emit<false>(ic_, C_, scr, F.lane); } \
        else { for (int j_ = 0; j_ < n_; ++j_) { ia_ = DECODE(F, f_ + j_ * g_); cvt_issue<false>(ia_, A_, F.lane); CVT_LANDED(A_, 0); cvt_emit<false>(ia_, A_, scr, F.lane); } } } } while (0)
__device__ __forceinline__ void rms_row_to_bf16(int lane, const float* xrow, const float* g, bf16* orow) {
    const GAS f32x4* xr = (const GAS f32x4*)xrow + lane;
    f32x4 v[8]; float s = 0.f;
#pragma unroll
    for (int j = 0; j < 8; ++j) { v[j] = __builtin_nontemporal_load(xr + 64 * j); s += (v[j].x * v[j].x + v[j].y * v[j].y) + (v[j].z * v[j].z + v[j].w * v[j].w); }
    const float rstd = 1.f / sqrtf(wave_sum(s) * (1.f / D) + RMS_EPS);
    GAS v2u* o8 = (GAS v2u*)orow + lane;
#pragma unroll
    for (int j = 0; j < 8; ++j) { const f32x4 gg = ((const GAS f32x4*)g)[64 * j + lane]; v2u w; w.x = pk2(v[j].x * rstd * gg.x, v[j].y * rstd * gg.y); w.y = pk2(v[j].z * rstd * gg.z, v[j].w * rstd * gg.w); o8[64 * j] = w; }
}
struct RowSet { f32x4 v[8]; };
__device__ __forceinline__ void row_issue(const float* xrow, RowSet& R, int lane) { const f32x4* p = (const f32x4*)xrow + lane;
#pragma unroll
    for (int j = 0; j < 8; ++j) asm volatile("global_load_dwordx4 %0, %1, off nt" : "=v"(R.v[j]) : "v"(p + 64 * j) : "memory"); }
#define ROW_LANDED(R, N) asm volatile("s_waitcnt vmcnt(" #N ")" : "+v"(R.v[0]), "+v"(R.v[1]), "+v"(R.v[2]), "+v"(R.v[3]), "+v"(R.v[4]), "+v"(R.v[5]), "+v"(R.v[6]), "+v"(R.v[7]) :: "memory")
__device__ __forceinline__ void row_emit(const RowSet& R, const f32x4 (&gg)[8], bf16* orow, int lane) {
    float s = 0.f;
#pragma unroll
    for (int j = 0; j < 8; ++j) s += (R.v[j].x * R.v[j].x + R.v[j].y * R.v[j].y) + (R.v[j].z * R.v[j].z + R.v[j].w * R.v[j].w);
    const float rstd = 1.f / sqrtf(wave_sum(s) * (1.f / D) + RMS_EPS);
    GAS v2u* o8 = (GAS v2u*)orow + lane;
#pragma unroll
    for (int j = 0; j < 8; ++j) { v2u w; w.x = pk2(R.v[j].x * rstd * gg[j].x, R.v[j].y * rstd * gg[j].y); w.y = pk2(R.v[j].z * rstd * gg[j].z, R.v[j].w * rstd * gg[j].w); o8[64 * j] = w; }
}
#define GG_ISSUE() do { const f32x4* gp_ = (const f32x4*)F.g_premix + lane; \
    _Pragma("unroll") for (int j_ = 0; j_ < 8; ++j_) asm volatile("global_load_dwordx4 %0, %1, off" : "=v"(gg[j_]) : "v"(gp_ + 64 * j_) : "memory"); } while (0)
__device__ __forceinline__ void p0_rows(Frame& F, int gw, int NGW) {
    if (gw >= M) return;
    const int n = (M - gw + NGW - 1) / NGW, lane = F.lane;
    f32x4 gg[8]; RowSet A, B;
    if (n >= 2) { int j = 0;
        GG_ISSUE(); row_issue(F.x + (size_t)gw * D, A, lane); row_issue(F.x + (size_t)(gw + NGW) * D, B, lane);
        ROW_LANDED(A, 8);
        asm volatile("" : "+v"(gg[0]), "+v"(gg[1]), "+v"(gg[2]), "+v"(gg[3]), "+v"(gg[4]), "+v"(gg[5]), "+v"(gg[6]), "+v"(gg[7]));
        row_emit(A, gg, F.XN + (size_t)gw * D, lane);
        while (j + 3 < n) {
            row_issue(F.x + (size_t)(gw + (j + 2) * NGW) * D, A, lane); ROW_LANDED(B, 16); row_emit(B, gg, F.XN + (size_t)(gw + (j + 1) * NGW) * D, lane);
            row_issue(F.x + (size_t)(gw + (j + 3) * NGW) * D, B, lane); ROW_LANDED(A, 16); row_emit(A, gg, F.XN + (size_t)(gw + (j + 2) * NGW) * D, lane);
            j += 2; }
        ROW_LANDED(B, 0); row_emit(B, gg, F.XN + (size_t)(gw + (j + 1) * NGW) * D, lane); j += 2;
        for (; j < n; ++j) { row_issue(F.x + (size_t)(gw + j * NGW) * D, A, lane); ROW_LANDED(A, 0); row_emit(A, gg, F.XN + (size_t)(gw + j * NGW) * D, lane); }
    } else {
        GG_ISSUE(); row_issue(F.x + (size_t)gw * D, A, lane); ROW_LANDED(A, 0);
        asm volatile("" : "+v"(gg[0]), "+v"(gg[1]), "+v"(gg[2]), "+v"(gg[3]), "+v"(gg[4]), "+v"(gg[5]), "+v"(gg[6]), "+v"(gg[7]));
        row_emit(A, gg, F.XN + (size_t)gw * D, lane); }
}
constexpr int I_IN = (D / 64) * (INW / 32), I_LG = 8 * 2 * 4, I_OUT = (D / 64) * (D / 32), I_G = (D / 64) * (FF / 32), I_DN = (FF / 64) * (D / 32);
__device__ __forceinline__ CvtItem decode_a(const Frame& F, int r) {
    if (r < I_IN) { const int kb = r / (INW / 32), nb = r % (INW / 32); return CvtItem{F.w_in, INW, F.WIN, D, 32 * nb, nullptr, 64 * kb, 32 * nb}; } r -= I_IN;
    if (r < I_LG) { const int blk = r >> 3, kb = (r >> 2) & 1, nb = r & 3; return CvtItem{F.w_rg + blk * 16384, 128, F.WRG + blk * 16384, 128, 32 * nb, nullptr, 64 * kb, 32 * nb}; } r -= I_LG;
    { const int blk = r >> 3, kb = (r >> 2) & 1, nb = r & 3; return CvtItem{F.w_ig + blk * 16384, 128, F.WIG + blk * 16384, 128, 32 * nb, nullptr, 64 * kb, 32 * nb}; }
}
__device__ __forceinline__ CvtItem decode_b(const Frame& F, int r) {
    if (r < I_OUT) { const int kb = r / (D / 32), nb = r % (D / 32); const int k0 = 64 * kb; const float* ks = (k0 < AW) ? F.g_attn + k0 : F.g_lru + (k0 - AW); return CvtItem{F.w_out, D, F.WOUT, D, 32 * nb, ks, k0, 32 * nb}; } r -= I_OUT;
    if (r < I_G) { const int kb = r / (FF / 32), nb = r % (FF / 32); const int n0 = 32 * nb; return CvtItem{F.w_gate, FF, F.WGU, D, (n0 >> 7) * 256 + (n0 & 127), F.g_preffn + 64 * kb, 64 * kb, n0}; } r -= I_G;
    { const int kb = r / (FF / 32), nb = r % (FF / 32); const int n0 = 32 * nb; return CvtItem{F.w_up, FF, F.WGU, D, (n0 >> 7) * 256 + 128 + (n0 & 127), F.g_preffn + 64 * kb, 64 * kb, n0}; }
}
__device__ __forceinline__ CvtItem decode_c(const Frame& F, int r) {
    const int kb = r / (D / 32), nb = r % (D / 32); return CvtItem{F.w_down, D, F.WDN, FF, 32 * nb, nullptr, 64 * kb, 32 * nb};
}
__device__ __forceinline__ void p0_prologue(Frame& F) {
    LAS float* scr = (LAS float*)(F.lds + RING_OFF + F.wave * 16384);
    const int gw = F.vcu * NWAVES + F.wave, NGW = F.G * NWAVES;
    CVT_FEW(decode_a, gw, I_IN + 2 * I_LG, NGW);
    p0_rows(F, gw, NGW);
    { GAS v4u* z = (GAS v4u*)(F.ws + WS_LAGG); const int gt = F.vcu * NWAVES * 64 + F.tid, NGT = F.G * NWAVES * 64;
      for (int i = gt; i < (int)(3 * MiB / 16); i += NGT) z[i] = (v4u){0u, 0u, 0u, 0u}; }
}
__device__ __forceinline__ void p0b_convert(Frame& F, int gw, int NGW) {
    LAS float* scr = (LAS float*)(F.lds + RING_OFF + F.wave * 16384);
    CVT_RUN(true, decode_b, gw, I_OUT + 2 * I_G, NGW, 20, 24, 28);
}
__device__ __forceinline__ void p0c_convert(Frame& F, int gw, int NGW) {
    LAS float* scr = (LAS float*)(F.lds + RING_OFF + F.wave * 16384);
    CVT_RUN(false, decode_c, gw, I_DN, NGW, 16, 20, 24);
}

__device__ __forceinline__ float softplus2(float z2) {
    float m; asm("v_max_f32_e32 %0, 0, %1" : "=v"(m) : "v"(z2));
    return m + __builtin_amdgcn_logf(1.0f + __builtin_amdgcn_exp2f(-fabsf(z2)));
}
__device__ __forceinline__ float gelu_tanh(float g) {
    const float g2 = g * g;
    const float t = g * (-2.0f * 1.4426950408889634f * 0.7978845608028654f - (2.0f * 1.4426950408889634f * 0.7978845608028654f * 0.044715f) * g2);
    return g * __builtin_amdgcn_rcpf(1.0f + __builtin_amdgcn_exp2f(t));
}
typedef short bf16x8 __attribute__((ext_vector_type(8)));
typedef float f32x16 __attribute__((ext_vector_type(16)));
__device__ __forceinline__ unsigned cvtpk(float lo, float hi) { return pk2(lo, hi); }
__device__ __forceinline__ void swap32(float v, float& lo, float& hi) {
    float a_ = v, b_ = v;
    asm volatile("s_nop 1\n\tv_permlane32_swap_b32 %0, %1\n\ts_nop 0" : "+v"(a_), "+v"(b_));
    lo = a_; hi = b_;
}
constexpr int AT_STAGE = 32768, AT_V = 16384, AT_FLAGS = 65536;
__device__ __forceinline__ void p2_attn_fast(Frame& F) {
    const int lane = F.lane, r32 = lane & 31, hi = lane >> 5, wave = F.wave;
    LAS unsigned char* L = F.lds;
    volatile LAS unsigned* FL = (volatile LAS unsigned*)(F.lds + AT_FLAGS);
    for (int item = F.vcu; item < 256; item += F.G) {
        const int bh = item & 15, qb = item >> 4;
        const int t0 = qb * 256 + wave * 32, qabs = t0 + r32;
        const int Tstart = 4 * qb + (wave >> 1), Ttop = 4 * qb + 3;
        bf16x8 qf[8];
        { const bf16* qp = F.Q + ((size_t)bh * 4096 + qabs) * 128 + 64 * hi;
#pragma unroll
          for (int d0 = 0; d0 < 8; ++d0) qf[d0] = *(const GAS bf16x8*)(qp + 8 * d0); }
        f32x16 o[4];
#pragma unroll
        for (int d0 = 0; d0 < 4; ++d0)
#pragma unroll
            for (int r = 0; r < 16; ++r) o[d0][r] = 0.f;
        float carry = 1.f; bool done = false;
        const unsigned char* Kt = (const unsigned char*)(F.K + (size_t)bh * 4096 * 128);
        const unsigned char* Vt = (const unsigned char*)(F.VT + (size_t)bh * 4096 * 128);
        unsigned srcK[2], srcV[2];
#pragma unroll
        for (int i = 0; i < 2; ++i) { const int p = wave + 8 * i;
            { const int row = 4 * p + (lane >> 4), pc = lane & 15; srcK[i] = (unsigned)(row * 256 + ((pc ^ (row & 15)) << 4)); }
            { const int row = 8 * p + (lane >> 3), pc = lane & 7; srcV[i] = (unsigned)(row * 128 + ((pc ^ ((row >> 1) & 7)) << 4)); } }
#define AT_LOAD(T, st) do { _Pragma("unroll") for (int i_ = 0; i_ < 2; ++i_) { \
            __builtin_amdgcn_global_load_lds((const unsigned*)(Kt + (size_t)(T) * 16384 + srcK[i_]), (LAS unsigned*)(L + (st) * AT_STAGE + (wave + 8 * i_) * 1024), 16, 0, 0); \
            __builtin_amdgcn_global_load_lds((const unsigned*)(Vt + (size_t)(T) * 16384 + srcV[i_]), (LAS unsigned*)(L + (st) * AT_STAGE + AT_V + (wave + 8 * i_) * 1024), 16, 0, 0); } } while (0)
        AT_LOAD(Ttop, 0);
        asm volatile("s_waitcnt vmcnt(0)" ::: "memory"); __syncthreads();
        int st = 0;
        const unsigned kx = (unsigned)(r32 & 15), vx = (unsigned)((r32 >> 1) & 7);
        for (int T = Ttop, step = 0; T >= 0; --T, ++step) {
            if (T > 0) AT_LOAD(T - 1, st ^ 1);
            if (T <= Tstart && !done) {
                const int key0 = T * 64;
                const LAS unsigned char* KS = L + st * AT_STAGE; const LAS unsigned char* VS = KS + AT_V;
                f32x16 p0, p1;
#pragma unroll
                for (int r = 0; r < 16; ++r) { p0[r] = 0.f; p1[r] = 0.f; }
                {
                  const unsigned kb_ = (unsigned)(uintptr_t)KS + (unsigned)(r32 * 256);
                  unsigned ka[8];
#pragma unroll
                  for (int d0 = 0; d0 < 8; ++d0) ka[d0] = kb_ + ((((unsigned)(8 * hi + d0)) ^ kx) << 4);
                  bf16x8 k0[8], k1[8];
#define RK_(d) asm volatile("ds_read_b128 %0, %2\n\tds_read_b128 %1, %2 offset:8192" : "=&v"(k0[d]), "=&v"(k1[d]) : "v"(ka[d]))
                  RK_(0); RK_(1); RK_(2); RK_(3);
                  asm volatile("s_waitcnt lgkmcnt(0)" : "+v"(k0[0]), "+v"(k1[0]), "+v"(k0[1]), "+v"(k1[1]), "+v"(k0[2]), "+v"(k1[2]), "+v"(k0[3]), "+v"(k1[3]) :: "memory");
                  RK_(4); RK_(5); RK_(6); RK_(7);
#pragma unroll
                  for (int d0 = 0; d0 < 4; ++d0) { p0 = __builtin_amdgcn_mfma_f32_32x32x16_bf16(k0[d0], qf[d0], p0, 0, 0, 0); p1 = __builtin_amdgcn_mfma_f32_32x32x16_bf16(k1[d0], qf[d0], p1, 0, 0, 0); }
                  asm volatile("s_waitcnt lgkmcnt(0)" : "+v"(k0[4]), "+v"(k1[4]), "+v"(k0[5]), "+v"(k1[5]), "+v"(k0[6]), "+v"(k1[6]), "+v"(k0[7]), "+v"(k1[7]) :: "memory");
#pragma unroll
                  for (int d0 = 4; d0 < 8; ++d0) { p0 = __builtin_amdgcn_mfma_f32_32x32x16_bf16(k0[d0], qf[d0], p0, 0, 0, 0); p1 = __builtin_amdgcn_mfma_f32_32x32x16_bf16(k1[d0], qf[d0], p1, 0, 0, 0); }
#undef RK_
                }
                const int lim = qabs - key0 - 4 * hi;
                const bool diag = key0 + 63 >= t0;
                float c0[16], c1[16], Tt[8];
                if (diag) {
#pragma unroll
                    for (int r = 0; r < 16; ++r) { const int kc = (r & 3) + 8 * (r >> 2);
                        p0[r] = (kc < lim) ? p0[r] : -__builtin_inff(); p1[r] = (kc + 32 < lim) ? p1[r] : -__builtin_inff(); } }
#pragma unroll
                for (int r = 0; r < 16; ++r) {
                    const float s0_ = p0[r], s1_ = p1[r];
                    const float z0 = __builtin_bit_cast(float, __builtin_elementwise_min(__builtin_bit_cast(int, s0_), 0x41f00000)), z1 = __builtin_bit_cast(float, __builtin_elementwise_min(__builtin_bit_cast(int, s1_), 0x41f00000));
                    const float e0 = __builtin_amdgcn_exp2f(z0), e1 = __builtin_amdgcn_exp2f(z1);
                    p0[r] = e0; p1[r] = e1; c0[r] = 1.0f + e0; c1[r] = 1.0f + e1; }
#pragma unroll
                for (int rr = 0; rr < 4; ++rr) {
                    { const float d0 = c0[4 * rr], d1 = c0[4 * rr + 1], d2 = c0[4 * rr + 2], d3 = c0[4 * rr + 3]; const float R = __builtin_amdgcn_rcpf(((d3 * d2) * d1) * d0);
                      const float i1 = R * d0, i2 = i1 * d1; c0[4 * rr] = R; c0[4 * rr + 1] = i1; c0[4 * rr + 2] = i2; c0[4 * rr + 3] = i2 * d2; Tt[rr] = R; }
                    { const float d0 = c1[4 * rr], d1 = c1[4 * rr + 1], d2 = c1[4 * rr + 2], d3 = c1[4 * rr + 3]; const float R = __builtin_amdgcn_rcpf(((d3 * d2) * d1) * d0);
                      const float i1 = R * d0, i2 = i1 * d1; c1[4 * rr] = R; c1[4 * rr + 1] = i1; c1[4 * rr + 2] = i2; c1[4 * rr + 3] = i2 * d2; Tt[4 + rr] = R; } }
                float off[8]; float acc = carry;
#pragma unroll
                for (int k = 7; k >= 0; --k) { float tl, th; swap32(Tt[k], tl, th); const float gh = acc; acc *= th; const float gl = acc; acc *= tl; off[k] = hi ? gh : gl; }
                carry = acc;
                unsigned pw[16];
#pragma unroll
                for (int rr = 0; rr < 4; ++rr) { const float o0 = off[rr], o1 = off[4 + rr];
                    const float a0 = p0[4 * rr] * (c0[4 * rr] * o0), a1 = p0[4 * rr + 1] * (c0[4 * rr + 1] * o0), a2 = p0[4 * rr + 2] * (c0[4 * rr + 2] * o0), a3 = p0[4 * rr + 3] * (c0[4 * rr + 3] * o0);
                    const float b0 = p1[4 * rr] * (c1[4 * rr] * o1), b1 = p1[4 * rr + 1] * (c1[4 * rr + 1] * o1), b2 = p1[4 * rr + 2] * (c1[4 * rr + 2] * o1), b3 = p1[4 * rr + 3] * (c1[4 * rr + 3] * o1);
                    pw[2 * rr] = cvtpk(a0, a1); pw[2 * rr + 1] = cvtpk(a2, a3); pw[8 + 2 * rr] = cvtpk(b0, b1); pw[8 + 2 * rr + 1] = cvtpk(b2, b3); }
                {
                  const unsigned vb_ = (unsigned)(uintptr_t)VS + (unsigned)(r32 * 128);
                  unsigned va_[4];
#pragma unroll
                  for (int ks = 0; ks < 4; ++ks) va_[ks] = vb_ + ((((unsigned)(2 * ks + hi)) ^ vx) << 4);
                  bf16x8 vf[4][4];
#define RV_(k) asm volatile("ds_read_b128 %0, %4\n\tds_read_b128 %1, %4 offset:4096\n\tds_read_b128 %2, %4 offset:8192\n\tds_read_b128 %3, %4 offset:12288" \
                      : "=&v"(vf[k][0]), "=&v"(vf[k][1]), "=&v"(vf[k][2]), "=&v"(vf[k][3]) : "v"(va_[k]))
                  RV_(0); RV_(1);
                  asm volatile("s_waitcnt lgkmcnt(0)" : "+v"(vf[0][0]), "+v"(vf[0][1]), "+v"(vf[0][2]), "+v"(vf[0][3]), "+v"(vf[1][0]), "+v"(vf[1][1]), "+v"(vf[1][2]), "+v"(vf[1][3]) :: "memory");
                  RV_(2); RV_(3);
#pragma unroll
                  for (int ks = 0; ks < 2; ++ks) { const v4u pu = (v4u){pw[4 * ks], pw[4 * ks + 1], pw[4 * ks + 2], pw[4 * ks + 3]}; const bf16x8 pb = __builtin_bit_cast(bf16x8, pu);
#pragma unroll
                      for (int d0 = 0; d0 < 4; ++d0) o[d0] = __builtin_amdgcn_mfma_f32_32x32x16_bf16(vf[ks][d0], pb, o[d0], 0, 0, 0); }
                  asm volatile("s_waitcnt lgkmcnt(0)" : "+v"(vf[2][0]), "+v"(vf[2][1]), "+v"(vf[2][2]), "+v"(vf[2][3]), "+v"(vf[3][0]), "+v"(vf[3][1]), "+v"(vf[3][2]), "+v"(vf[3][3]) :: "memory");
#pragma unroll
                  for (int ks = 2; ks < 4; ++ks) { const v4u pu = (v4u){pw[4 * ks], pw[4 * ks + 1], pw[4 * ks + 2], pw[4 * ks + 3]}; const bf16x8 pb = __builtin_bit_cast(bf16x8, pu);
#pragma unroll
                      for (int d0 = 0; d0 < 4; ++d0) o[d0] = __builtin_amdgcn_mfma_f32_32x32x16_bf16(vf[ks][d0], pb, o[d0], 0, 0, 0); }
#undef RV_
                }
                if (__all(carry == 0.0f)) done = true;
            }
            if (lane == 0) FL[(step & 1) * 8 + wave] = (done || T == 0) ? 1u : 0u;
            asm volatile("s_waitcnt vmcnt(0) lgkmcnt(0)" ::: "memory"); __syncthreads();
            unsigned alld = 1u;
#pragma unroll
            for (int w = 0; w < 8; ++w) alld &= FL[(step & 1) * 8 + w];
            if (__builtin_amdgcn_readfirstlane(alld)) break;
            st ^= 1;
        }
#undef AT_LOAD
        float ss = 0.f;
        { LAS unsigned char* op = L + wave * 8704 + r32 * 272 + 8 * hi;
#pragma unroll
          for (int d0 = 0; d0 < 4; ++d0)
#pragma unroll
              for (int rr = 0; rr < 4; ++rr) { const float a = o[d0][4 * rr], b2 = o[d0][4 * rr + 1], c = o[d0][4 * rr + 2], d = o[d0][4 * rr + 3];
                  ss += (a * a + b2 * b2) + (c * c + d * d); v2u w; w.x = cvtpk(a, b2); w.y = cvtpk(c, d); *(LAS v2u*)(op + d0 * 64 + rr * 16) = w; }
          asm volatile("s_waitcnt lgkmcnt(0)" ::: "memory");
          const LAS unsigned char* ip = L + wave * 8704 + (lane >> 4) * 272 + (lane & 15) * 16;
          bf16* yrow = F.Y + ((size_t)(bh >> 3) * SEQ + t0 + (lane >> 4)) * 2048 + (bh & 7) * 128 + (lane & 15) * 8;
#pragma unroll
          for (int j = 0; j < 8; ++j) { const v4u w = *(const LAS v4u*)(ip + j * 4 * 272); *(GAS v4u*)(yrow + (size_t)j * 4 * 2048) = w; } }
        { float sl_, sh_; swap32(ss, sl_, sh_); ss = sl_ + sh_; }
        if (hi == 0) F.SSQA[((size_t)(bh >> 3) * SEQ + qabs) * 8 + (bh & 7)] = ss;
        __syncthreads();
    }
}

constexpr int L3_XCF = 0, L3_XCB = 32768, L3_W = 50176, L3_BLK = 119808  , L3_LB = 123904, L3_LD = 136, L3_WLD = 136;
__device__ __forceinline__ void lru_stage_weights(Frame& F, int blk) {
    const int tid = F.tid; LAS bf16* WL = (LAS bf16*)(F.lds + L3_W);
    v4u wv[8];
#pragma unroll
    for (int k = 0; k < 8; ++k) { const int idx = tid + 512 * k, gsel = idx >> 11, row = (idx >> 4) & 127, chk = idx & 15;
        wv[k] = *(const GAS v4u*)((gsel ? F.WIG : F.WRG) + blk * 16384 + row * 128 + 8 * chk); }
    asm volatile("s_waitcnt vmcnt(0)" : "+v"(wv[0]), "+v"(wv[1]), "+v"(wv[2]), "+v"(wv[3]), "+v"(wv[4]), "+v"(wv[5]), "+v"(wv[6]), "+v"(wv[7]) :: "memory");
#pragma unroll
    for (int k = 0; k < 8; ++k) { const int idx = tid + 512 * k, gsel = idx >> 11, row = (idx >> 4) & 127, chk = idx & 15;
        *(LAS v4u*)(WL + (gsel * 128 + row) * L3_WLD + 8 * chk) = wv[k]; }
}
#define LBAR() do { asm volatile("s_waitcnt lgkmcnt(0)" ::: "memory"); __builtin_amdgcn_s_barrier(); asm volatile("" ::: "memory"); } while (0)
__device__ __forceinline__ void p2_lru_fast(Frame& F, int staged_bb) {
    const int tid = F.tid, wave = F.wave;
    LAS float* XCF = (LAS float*)(F.lds + L3_XCF); LAS bf16* XCB = (LAS bf16*)(F.lds + L3_XCB); LAS bf16* WL = (LAS bf16*)(F.lds + L3_W);
    LAS float* BLKP = (LAS float*)(F.lds + L3_BLK); LAS float* BLKH = BLKP + 256;
    LAS float* LBP = (LAS float*)(F.lds + L3_LB); LAS float* LBH = LBP + 512;
    gu64* AGG = (gu64*)(F.ws + WS_LAGG);
    gu64* INC = (gu64*)(F.ws + WS_LAGG + 2 * MiB);
    int cur_bb = -1;
    float w0[4], w1[4], cb0 = 0.f, cb1 = 0.f, cl2 = 0.f, br_ = 0.f, bi_ = 0.f;
    unsigned xw[11];
#define LRU_XLOAD(IT) do { int t2_ = tid; asm volatile("" : "+v"(t2_)); const int c_ = (IT) >> 4, b_ = ((IT) >> 3) & 1, blk_ = (IT) & 7; \
        const bf16* xb_ = F.XL + ((size_t)b_ * SEQ + c_ * 64 + 8 * wave) * 1024 + blk_ * 128; const unsigned xo_ = 2u * (unsigned)(t2_ & 63);     \
        if (c_ * 64 + 8 * wave >= 3) {     \
            _Pragma("unroll") for (int j = 0; j < 11; ++j) xw[j] = *(const GAS unsigned*)(xb_ + (j - 3) * 1024 + xo_); } \
        else { _Pragma("unroll") for (int j = 0; j < 11; ++j) { const int t = c_ * 64 + 8 * wave - 3 + j; xw[j] = 0u; if (t >= 0) xw[j] = *(const GAS unsigned*)(xb_ + (j - 3) * 1024 + xo_); } } } while (0)
    if (F.vcu < 1024) LRU_XLOAD(F.vcu);
    float PCp[16], HLp[16];
#pragma unroll
    for (int r = 0; r < 16; ++r) { PCp[r] = 0.f; HLp[r] = 0.f; }
    bool pv = false; int par = 0;
    for (int it = F.vcu; ; it += F.G) {
        const bool cv = it < 1024;
        if (!cv && !pv) break;
        int tid_ = tid; asm volatile("" : "+v"(tid_));
        const int lane = tid_ & 63, r32 = lane & 31, hi = lane >> 5;
        const int ch2 = tid_ & 63, tg = wave;
        const int tm = wave >> 2, cn = wave & 3, chl = 32 * cn + r32;
        const int chq = tid_ & 127, q = wave >> 1;
        LAS float* BKP = BLKP + par * 512; LAS float* BKH = BKP + 256;
        const LAS float* BQP = BLKP + (par ^ 1) * 512; const LAS float* BQH = BQP + 256;
        const int itp = pv ? it - F.G : 0;
        const int cp = itp >> 4, bp = (itp >> 3) & 1, blkp = itp & 7, bbp = bp * 8 + blkp; const size_t row0p = (size_t)bp * SEQ + cp * 64; const int crp_ = cp & ~15;
        gu64* aggp = AGG + ((size_t)bbp * 64) * 256; gu64* incp = INC + ((size_t)bbp * 64) * 128;
        gu64* aggq = aggp + (size_t)(crp_ + 4 * q) * 256;
        const int crp = cp & ~15;
        const int lb0 = cp - crp - 4 * q; const int lbn = pv ? (lb0 < 4 ? (lb0 < 0 ? 0 : lb0) : 4) : 0;
        const bool useinc = pv && q == 0 && crp > 0;
        constexpr unsigned long long LANDED = 1ull << 32;
        unsigned long long gp[4] = {LANDED, LANDED, LANDED, LANDED}, gh[4] = {LANDED, LANDED, LANDED, LANDED}, gi = LANDED;
        const int c = it >> 4, b = (it >> 3) & 1, blk = it & 7, bb = b * 8 + blk;
        const int t0 = c * 64; const size_t row0 = (size_t)b * SEQ + t0;
        gu64* agg = AGG + ((size_t)bb * 64) * 256;
        unsigned gq[16];
        float PC[16], HL[16];
        if (cv) {
        if (bb != cur_bb) { cur_bb = bb;
            const int cg = blk * 128 + 2 * ch2;
#pragma unroll
            for (int k = 0; k < 4; ++k) { w0[k] = F.conv_w[k * LW + cg]; w1[k] = F.conv_w[k * LW + cg + 1]; }
            cb0 = F.conv_b[cg]; cb1 = F.conv_b[cg + 1];
            const int chg = blk * 128 + chl; const float lam = F.lam[chg];
            cl2 = -8.0f * 1.4426950408889634f * (fmaxf(-lam, 0.f) + log1pf(expf(-fabsf(lam))));
            br_ = -1.4426950408889634f * F.b_rg[chg]; bi_ = -1.4426950408889634f * F.b_ig[chg];
            if (bb != staged_bb) lru_stage_weights(F, blk); }
        {
#pragma unroll
          for (int i = 0; i < 8; ++i) { float a0 = cb0, a1 = cb1;
#pragma unroll
              for (int k = 0; k < 4; ++k) { a0 += w0[k] * bflo(xw[i + k]); a1 += w1[k] * bfhi(xw[i + k]); }
              const int tl = 8 * tg + i; *(LAS f32x2*)(XCF + tl * 128 + 2 * ch2) = (f32x2){a0, a1}; *(LAS unsigned*)(XCB + tl * L3_LD + 2 * ch2) = pk2(a0, a1); } }
        }
        { const size_t rq = pv ? row0p : row0; const int bq = pv ? blkp : blk;
          const bf16* gb = F.GL + (rq + 32 * tm) * 1024 + bq * 128; const unsigned go = (unsigned)(4 * hi * 1024 + chl);
#pragma unroll
          for (int r = 0; r < 16; ++r) gq[r] = (unsigned)gb[go + (unsigned)(((r & 3) + 8 * (r >> 2)) * 1024)]; }
#pragma unroll
        for (int k = 0; k < 4; ++k) if (k < lbn) { gp[k] = __hip_atomic_load(aggq + k * 256 + chq, RLX_AGENT); gh[k] = __hip_atomic_load(aggq + k * 256 + 128 + chq, RLX_AGENT); }
        if (useinc) gi = __hip_atomic_load(incp + (size_t)(crp - 1) * 128 + chq, RLX_AGENT);
        LBAR();
        if (cv) { f32x16 aR, aI;
#pragma unroll
          for (int r = 0; r < 16; ++r) { aR[r] = 0.f; aI[r] = 0.f; }
          const unsigned apa = (unsigned)(uintptr_t)(XCB + (32 * tm + r32) * L3_LD + 64 * hi), rpa = (unsigned)(uintptr_t)(WL + chl * L3_WLD + 64 * hi), ipa = rpa + 128 * L3_WLD * 2;
          bf16x8 fa[4], fr[4], fi[4];
#define RG_(k) asm volatile("ds_read_b128 %0, %3 offset:%c6\n\tds_read_b128 %1, %4 offset:%c6\n\tds_read_b128 %2, %5 offset:%c6" : "=&v"(fa[(k) & 3]), "=&v"(fr[(k) & 3]), "=&v"(fi[(k) & 3]) : "v"(apa), "v"(rpa), "v"(ipa), "i"(16 * (k)))
#define WG_(k) asm volatile("s_waitcnt lgkmcnt(0)" : "+v"(fa[(k) & 3]), "+v"(fr[(k) & 3]), "+v"(fi[(k) & 3]), "+v"(fa[((k) + 1) & 3]), "+v"(fr[((k) + 1) & 3]), "+v"(fi[((k) + 1) & 3]) :: "memory")
#define MG_(k) do { aR = __builtin_amdgcn_mfma_f32_32x32x16_bf16(fa[(k) & 3], fr[(k) & 3], aR, 0, 0, 0); aI = __builtin_amdgcn_mfma_f32_32x32x16_bf16(fa[(k) & 3], fi[(k) & 3], aI, 0, 0, 0); } while (0)
          RG_(0); RG_(1); WG_(0); RG_(2); RG_(3); MG_(0); MG_(1); WG_(2); RG_(4); RG_(5); MG_(2); MG_(3); WG_(4); RG_(6); RG_(7); MG_(4); MG_(5); WG_(6); MG_(6); MG_(7);
#undef RG_
#undef WG_
#undef MG_
          float Pg[4], Hg[4];
#pragma unroll
          for (int g = 0; g < 4; ++g) { float pp = 1.f, hh = 0.f;
#pragma unroll
              for (int i = 0; i < 4; ++i) { const int r = 4 * g + i; const int tl = 32 * tm + i + 8 * g + 4 * hi;
                  const float rg = __builtin_amdgcn_rcpf(1.0f + __builtin_amdgcn_exp2f(__builtin_fmaf(aR[r], -1.4426950408889634f, br_)));
                  const float ig = __builtin_amdgcn_rcpf(1.0f + __builtin_amdgcn_exp2f(__builtin_fmaf(aI[r], -1.4426950408889634f, bi_)));
                  const float a = __builtin_amdgcn_exp2f(cl2 * rg);
                  const float om = __builtin_fmaf(-a, a, 1.0f);
                  const float bt = __builtin_amdgcn_sqrtf(om) * (ig * XCF[tl * 128 + chl]);
                  pp *= a; hh = a * hh + bt; PC[r] = pp; HL[r] = hh; }
              Pg[g] = pp; Hg[g] = hh; }
          float C = 1.f, S = 0.f;
#pragma unroll
          for (int g = 0; g < 4; ++g) { float pl, ph, hl_, hh_; swap32(Pg[g], pl, ph); swap32(Hg[g], hl_, hh_);
              const float C0 = C, S0 = S; S = pl * S + hl_; C = C * pl;
              const float C1 = C, S1 = S; S = ph * S + hh_; C = C * ph;
              const float Cin = hi ? C1 : C0, Sin = hi ? S1 : S0;
#pragma unroll
              for (int i = 0; i < 4; ++i) { const int r = 4 * g + i; HL[r] = HL[r] + PC[r] * Sin; PC[r] = PC[r] * Cin; } }
          if (hi == 0) { BKP[tm * 128 + chl] = C; BKH[tm * 128 + chl] = S; } }
        LBAR();
        if (cv) {
        if (tid < 128) { const float p0_ = BKP[tid], h0_ = BKH[tid], p1_ = BKP[128 + tid], h1_ = BKH[128 + tid];
            __hip_atomic_store(agg + (size_t)c * 256 + tid, (1ull << 32) | __builtin_bit_cast(unsigned, p0_ * p1_), RLX_AGENT);
            __hip_atomic_store(agg + (size_t)c * 256 + 128 + tid, (1ull << 32) | __builtin_bit_cast(unsigned, p1_ * h0_ + h1_), RLX_AGENT); }
        }
        float gelp[16];
#pragma unroll
        for (int r = 0; r < 16; ++r) gelp[r] = gelu_tanh(__builtin_bit_cast(float, gq[r] << 16));
        if (pv) { unsigned spins = 0;
          const unsigned tags = (unsigned)(gp[0] >> 32) & (unsigned)(gp[1] >> 32) & (unsigned)(gp[2] >> 32) & (unsigned)(gp[3] >> 32) & (unsigned)(gh[0] >> 32) & (unsigned)(gh[1] >> 32) & (unsigned)(gh[2] >> 32) & (unsigned)(gh[3] >> 32) & (unsigned)(gi >> 32);
          if (tags != 1u)
          for (;;) { bool ok = true;
#pragma unroll
              for (int k = 0; k < 4; ++k) if (k < lbn) { if ((gp[k] >> 32) != 1ull) gp[k] = __hip_atomic_load(aggq + k * 256 + chq, RLX_AGENT);
                  if ((gh[k] >> 32) != 1ull) gh[k] = __hip_atomic_load(aggq + k * 256 + 128 + chq, RLX_AGENT); ok = ok && ((gp[k] >> 32) == 1ull) && ((gh[k] >> 32) == 1ull); }
              if (useinc) { if ((gi >> 32) != 1ull) gi = __hip_atomic_load(incp + (size_t)(crp - 1) * 128 + chq, RLX_AGENT); ok = ok && ((gi >> 32) == 1ull); }
              if (ok) break;
              __builtin_amdgcn_s_sleep(2);
              if (++spins > (1u << 20)) { if (tid == 0) __hip_atomic_store(F.ctl + CW_TMO, 1u, RLX_AGENT); break; } }
          float P = 1.f, h = useinc ? __builtin_bit_cast(float, (unsigned)gi) : 0.f;
          if (useinc) P = 0.f;
#pragma unroll
          for (int k = 0; k < 4; ++k) if (k < lbn) { const float pk = __builtin_bit_cast(float, (unsigned)gp[k]), hk = __builtin_bit_cast(float, (unsigned)gh[k]); P *= pk; h = pk * h + hk; }
          LBP[q * 128 + chq] = P; LBH[q * 128 + chq] = h; }
        if (cv && it + F.G < 1024) LRU_XLOAD(it + F.G);
        LBAR();
        if (pv) {
        if (tid < 128 && (cp & 15) == 15) { float h = 0.f;
#pragma unroll
            for (int s = 0; s < 4; ++s) h = LBP[s * 128 + tid] * h + LBH[s * 128 + tid];
            h = BQP[tid] * h + BQH[tid]; h = BQP[128 + tid] * h + BQH[128 + tid];
            __hip_atomic_store(incp + (size_t)cp * 128 + tid, (1ull << 32) | __builtin_bit_cast(unsigned, h), RLX_AGENT); }
        float hs = 0.f;
#pragma unroll
        for (int s = 0; s < 4; ++s) hs = LBP[s * 128 + chl] * hs + LBH[s * 128 + chl];
        if (tm == 1) hs = BQP[chl] * hs + BQH[chl];
#pragma unroll
        for (int r = 0; r < 16; ++r) { const int tl = 32 * tm + (r & 3) + 8 * (r >> 2) + 4 * hi; const float y = (HLp[r] + PCp[r] * hs) * gelp[r];
            XCB[tl * L3_LD + chl] = (bf16)f2bf(y); XCF[tl * 128 + chl] = y * y; }
        }
        LBAR();
        if (pv) {
        {
          const int row = tid_ >> 3, pc = tid_ & 7; const LAS unsigned char* ip = (const LAS unsigned char*)(XCB + row * L3_LD) + pc * 32;
          const v4u y0 = *(const LAS v4u*)ip, y1 = *(const LAS v4u*)(ip + 16);
          bf16* yb = F.Y + row0p * 2048 + 1024 + blkp * 128; GAS v4u* yo = (GAS v4u*)(yb + (unsigned)(row * 2048 + pc * 16)); yo[0] = y0; yo[1] = y1; }
        { const int t = tid >> 3, part = tid & 7; const LAS f32x4* p = (const LAS f32x4*)(XCF + t * 128 + 16 * part); const f32x4 a = p[0], b4 = p[1], c4 = p[2], d4 = p[3];
          float s = ((a.x + a.y) + (a.z + a.w)) + ((b4.x + b4.y) + (b4.z + b4.w)) + ((c4.x + c4.y) + (c4.z + c4.w)) + ((d4.x + d4.y) + (d4.z + d4.w));
          s = sum8(s);
          if (part == 0) (F.SSQL + row0p * 8 + blkp)[(unsigned)(t * 8)] = s; }
        }
        LBAR();
#pragma unroll
        for (int r = 0; r < 16; ++r) if (cv) { PCp[r] = PC[r]; HLp[r] = HL[r]; }
        pv = cv; par ^= 1;
    }
}
#undef LRU_XLOAD
#undef LBAR

__device__ __forceinline__ void p3_row_table(Frame& F, int pm) {
    LAS f32x2* RS = (LAS f32x2*)(F.lds + RS_OFF);
    if (F.tid < 256) { const size_t row = (size_t)pm * 256 + F.tid; const GAS f32x4* a = (const GAS f32x4*)(F.SSQA + row * 8); const GAS f32x4* l = (const GAS f32x4*)(F.SSQL + row * 8);
        const f32x4 a0 = a[0], a1 = a[1], l0 = l[0], l1 = l[1];
        const float sa = ((a0.x + a0.y) + (a0.z + a0.w)) + ((a1.x + a1.y) + (a1.z + a1.w)), sl = ((l0.x + l0.y) + (l0.z + l0.w)) + ((l1.x + l1.y) + (l1.z + l1.w));
        const float ra = 1.f / sqrtf(sa * (1.f / AW) + RMS_EPS), rl = 1.f / sqrtf(sl * (1.f / LW) + RMS_EPS);
        RS[F.tid] = (f32x2){ra / rl, rl}; }
    __syncthreads();
}

constexpr int PH_P0 = 0, PH_P1 = 1, PH_P2 = 2, PH_P3 = 3, PH_P4 = 4, PH_P5 = 5, N_PHASES = 6;
constexpr int CW_SEAM = 16384, SEAM_BANK = 2048;
struct Args { const float* in[19]; float* out; unsigned char* ws; int ph_lo, ph_hi, li, pad; };
__global__ void __launch_bounds__(NWAVES * 64, 2) hymba_fwd(Args args) {
    extern __shared__ __attribute__((aligned(16))) unsigned char lds[];
    Frame F;
    F.lds = (LAS unsigned char*)lds;
    F.MISC = (volatile LAS unsigned*)(F.lds + MISC_OFF);
    F.tid = threadIdx.x; F.lane = F.tid & 63; F.wave = __builtin_amdgcn_readfirstlane(F.tid >> 6);
    F.G = gridDim.x; { const int bx = blockIdx.x; F.vcu = (F.G % 8 == 0) ? (bx % 8) * (F.G / 8) + bx / 8 : bx; }
    unsigned char* ws = args.ws; F.ws = ws;
    F.ctl = (gu32*)(ws + WS_CTL);
    F.x = args.in[0]; F.g_premix = args.in[1]; F.g_postmix = args.in[2]; F.g_preffn = args.in[3]; F.g_postffn = args.in[4]; F.w_in = args.in[5]; F.conv_w = args.in[6]; F.conv_b = args.in[7];
    F.w_rg = args.in[8]; F.b_rg = args.in[9]; F.w_ig = args.in[10]; F.b_ig = args.in[11]; F.lam = args.in[12]; F.g_attn = args.in[13]; F.g_lru = args.in[14]; F.w_out = args.in[15];
    F.w_gate = args.in[16]; F.w_up = args.in[17]; F.w_down = args.in[18]; F.out = args.out;
    F.WIN = (bf16*)(ws + WS_WIN); F.WOUT = (bf16*)(ws + WS_WOUT); F.WGU = (bf16*)(ws + WS_WGU); F.WDN = (bf16*)(ws + WS_WDN); F.WRG = (bf16*)(ws + WS_WRG); F.WIG = (bf16*)(ws + WS_WIG);
    F.XN = (bf16*)(ws + WS_XN); F.Q = (bf16*)(ws + WS_Q); F.K = (bf16*)(ws + WS_K); F.VT = (bf16*)(ws + WS_VT); F.XL = (bf16*)(ws + WS_XL); F.GL = (bf16*)(ws + WS_GL); F.Y = (bf16*)(ws + WS_Y); F.H = (bf16*)(ws + WS_H);
    F.SSQA = (float*)(ws + WS_SSQA); F.SSQL = (float*)(ws + WS_SSQL); F.XCH = (float*)(ws + WS_XCH);
    for (int u = F.tid; u < (LDS_BYTES - LDSCTL_OFF) / 4; u += NWAVES * 64) ((LAS unsigned*)(F.lds + LDSCTL_OFF))[u] = 0u;
    __syncthreads();
    const bool one_launch = (MK_N_LAUNCHES == 1);
    XcdBarrier bar; bar.bar = (unsigned*)(F.ctl + CW_BAR); bar.x = 0; bar.st = nullptr;
    if (one_launch) bar = xcd_barrier_post((unsigned*)(F.ctl + CW_BAR), F.MISC + 8);
    const int lo = args.ph_lo, hi = args.ph_hi;
#define IN(k) (lo <= (k) && (k) < hi)
#define SEAM(k) do { if (IN(k) && IN((k) + 1)) xcd_barrier(bar, (unsigned)((k) - lo)); } while (0)

    if (IN(PH_P0)) { p0_prologue(F); } SEAM(PH_P0);
    if (IN(PH_P1)) {
        pg8::Gemm g{F.XN, F.WIN, M, INW, D}; pg8::StaticOrder S; S.init(M, INW, F.G, (int)blockIdx.x, WGM_P1);
        pg8::EpiInProj E{F.Q, F.K, F.VT, F.XL, F.GL};
        pg8::gemm_phase<pg8::EpiInProj, pg8::StaticOrder, true, true>(F.lds + RING_OFF, g, S, E);
        { const int nwg = (M / 256) * (INW / 256), rem = nwg % F.G; const int c = (int)blockIdx.x;
          if (rem == 0) p0b_convert(F, c * NWAVES + F.wave, F.G * NWAVES);
          else if (c >= rem) p0b_convert(F, (c - rem) * NWAVES + F.wave, (F.G - rem) * NWAVES); }
        if (IN(PH_P2)) { __syncthreads(); if (F.vcu < 1024) lru_stage_weights(F, F.vcu & 7); }
    } SEAM(PH_P1);
        if (IN(PH_P2)) { p2_lru_fast(F, (IN(PH_P1) && F.vcu < 1024) ? (((F.vcu >> 3) & 1) * 8 + (F.vcu & 7)) : -1); p2_attn_fast(F); } SEAM(PH_P2);
    if (IN(PH_P3)) {
        pg8::Gemm g{F.Y, F.WOUT, M, D, D}; pg8::StaticOrder S; S.init(M, D, F.G, (int)blockIdx.x, WGM_P3);
        pg8::Unit u0; if (S.next(0, u0)) p3_row_table(F, u0.pm); else __syncthreads();
        pg8::PanelSsq st1{(unsigned*)(F.ws + WS_XG), (unsigned*)(F.ctl + CW_SEAM), (unsigned*)(F.ctl + CW_TMO), 0x740u};
        pg8::EpiOutNorm2 E{F.x, F.XN, F.XCH + (size_t)M * 8, F.g_postmix, st1, F.lds};
        pg8::gemm_phase<pg8::EpiOutNorm2, pg8::StaticOrder, false, true>(F.lds + RING_OFF, g, S, E);
    } SEAM(PH_P3);
    if (IN(PH_P4)) {
        pg8::Gemm g{F.XN, F.WGU, M, GUW, D}; pg8::StaticOrder S; S.init(M, GUW, F.G, (int)blockIdx.x, WGM_P4);
        const float* xss = F.XCH + (size_t)M * 8;
        pg8::Unit u0; int tpm = -1;
        if (S.next(0, u0)) { tpm = u0.pm;
            if (F.tid < 256) { const size_t row = (size_t)tpm * 256 + F.tid; const GAS f32x4* a = (const GAS f32x4*)(xss + row * 8); const f32x4 a0 = a[0], a1 = a[1];
                ((LAS float*)(F.lds + RS_OFF))[F.tid] = 1.f / sqrtf((((a0.x + a0.y) + (a0.z + a0.w)) + ((a1.x + a1.y) + (a1.z + a1.w))) * (1.f / D) + RMS_EPS); } }
        __syncthreads();
        pg8::EpiSwiGLU2 E{F.H, F.lds, xss, tpm};
        pg8::gemm_phase<pg8::EpiSwiGLU2, pg8::StaticOrder, true, true>(F.lds + RING_OFF, g, S, E);
        { const int nwg = (M / 256) * (GUW / 256), rem = nwg % F.G; const int c = (int)blockIdx.x;
          if (rem == 0) p0c_convert(F, c * NWAVES + F.wave, F.G * NWAVES);
          else if (c >= rem) p0c_convert(F, (c - rem) * NWAVES + F.wave, (F.G - rem) * NWAVES); }
    } SEAM(PH_P4);
    if (IN(PH_P5)) {
        pg8::Gemm g{F.H, F.WDN, M, D, FF}; pg8::StaticOrder S; S.init(M, D, F.G, (int)blockIdx.x, WGM_P5);
        pg8::PanelSsq st{(unsigned*)(F.ws + WS_XG + 256 * 1024), (unsigned*)(F.ctl + CW_SEAM + 2 * SEAM_BANK), (unsigned*)(F.ctl + CW_TMO), 0x700u};
        pg8::EpiDownNorm2 E{F.out, F.XN, F.g_postffn, st};
        pg8::gemm_phase<pg8::EpiDownNorm2, pg8::StaticOrder, false, true>(F.lds + RING_OFF, g, S, E);
    }
#undef IN
#undef SEAM
}

extern "C" void kernel_launch(void* const* d_in, const int* in_sizes, int n_in, void* d_out, int out_size, void* d_ws, size_t ws_size, hipStream_t stream) {
    static int grid = 0;
    if (grid == 0) {
        if (n_in != 19 || in_sizes[0] != M * D || out_size != M * D || ws_size < WS_END) { fprintf(stderr, "kernel_launch: unexpected shapes (n_in %d, in0 %d, out %d, ws %zu); nothing launched\n", n_in, n_in > 0 ? in_sizes[0] : -1, out_size, ws_size); grid = -1; return; }
        int dev = 0, cus = 0, per_cu = 0;
        if (hipGetDevice(&dev) != hipSuccess || hipDeviceGetAttribute(&cus, hipDeviceAttributeMultiprocessorCount, dev) != hipSuccess) { grid = -1; return; }
        if (hipFuncSetAttribute((const void*)hymba_fwd, hipFuncAttributeMaxDynamicSharedMemorySize, LDS_BYTES) != hipSuccess) { fprintf(stderr, "kernel_launch: hipFuncSetAttribute failed\n"); grid = -1; return; }
        if (hipOccupancyMaxActiveBlocksPerMultiprocessor(&per_cu, (const void*)hymba_fwd, NWAVES * 64, LDS_BYTES) != hipSuccess || per_cu < 1)
            fprintf(stderr, "kernel_launch: note: occupancy query reports %d workgroups per CU\n", per_cu);
        (void)hipGetLastError();
        grid = cus;
    }
    if (grid < 0) return;
    if (hipMemsetAsync((char*)d_ws + WS_CTL, 0, CTL_ZERO_BYTES, stream) != hipSuccess) { fprintf(stderr, "kernel_launch: hipMemsetAsync failed\n"); return; }
    Args a{};
    for (int i = 0; i < 19; ++i) a.in[i] = (const float*)d_in[i];
    a.out = (float*)d_out; a.ws = (unsigned char*)d_ws;
#if MK_N_LAUNCHES == 1
    a.ph_lo = 0; a.ph_hi = N_PHASES; a.li = 0;
    hipLaunchKernelGGL(hymba_fwd, dim3(grid), dim3(NWAVES * 64), LDS_BYTES, stream, a);
#else
    for (int li = 0; li < N_PHASES; ++li) { a.ph_lo = li; a.ph_hi = li + 1; a.li = li;
        hipLaunchKernelGGL(hymba_fwd, dim3(grid), dim3(NWAVES * 64), LDS_BYTES, stream, a); }
#endif
    const hipError_t le = hipPeekAtLastError();
    if (le != hipSuccess) fprintf(stderr, "kernel_launch: launch failed: %s\n", hipGetErrorName(le));
}
```
